# Optimizing an MI355X kernel written in HIP

```python
import jax, jax.numpy as jnp
from jax import lax
import numpy as np

D_MODEL = 2048
BATCH = 2
SEQ = 16384
DEPTH = 1

CTX_LEN = 256
GRID_W = 64
ROPE_BASE = 10000.0
EPS = 1e-6
NEG = -1e30
BLOCK = 128

MLA_HEADS = 8
MLA_NOPE = 128
MLA_ROPE = 64
MLA_V = 128
MLA_Q_RANK = 512
MLA_KV_RANK = 512
MLA_WIDTH = MLA_HEADS * MLA_V

SWA_HEADS = 16
SWA_KV_HEADS = 4
SWA_GROUP = SWA_HEADS // SWA_KV_HEADS
SWA_HEAD_DIM = 64
SWA_WIDTH = SWA_HEADS * SWA_HEAD_DIM
SWA_KV_WIDTH = SWA_KV_HEADS * SWA_HEAD_DIM
WINDOW = 128

IN_SPLITS = (MLA_Q_RANK, MLA_KV_RANK, MLA_ROPE, MLA_WIDTH,
             SWA_WIDTH, SWA_KV_WIDTH, SWA_KV_WIDTH, SWA_WIDTH,
             D_MODEL, D_MODEL)
IN_WIDTH = 512 + 512 + 64 + 1024 + 1024 + 256 + 256 + 1024 + 2 * D_MODEL

kernel_name = "hybrid_mla_swa_sink_gated_dit_block"


def _rmsnorm(x, g):
    xf = x.astype(jnp.float32)
    y = xf * lax.rsqrt(jnp.mean(xf * xf, axis=-1, keepdims=True) + EPS)
    return (y * g.astype(jnp.float32)).astype(x.dtype)


def _rope_half(x, pos):
    n = x.shape[-1] // 2
    inv = ROPE_BASE ** (-jnp.arange(n, dtype=jnp.float32) / n)
    ang = pos.astype(jnp.float32)[:, None] * inv[None, :]
    shape = (x.shape[1],) + (1,) * (x.ndim - 3) + (n,)
    cos = jnp.cos(ang).reshape(shape).astype(x.dtype)
    sin = jnp.sin(ang).reshape(shape).astype(x.dtype)
    x1, x2 = x[..., :n], x[..., n:]
    return jnp.concatenate([x1 * cos - x2 * sin, x2 * cos + x1 * sin], axis=-1)


def _rope_2d(x, rows, cols):
    a = x.shape[-1] // 2
    return jnp.concatenate([_rope_half(x[..., :a], rows), _rope_half(x[..., a:], cols)], axis=-1)


def _branch_inputs(h, w_in, b_in, qn_g, kvn_g, w_uq, w_ukv):
    B, S, _ = h.shape
    offsets, acc = [], 0
    for w in IN_SPLITS[:-1]:
        acc += w
        offsets.append(acc)
    z = h @ w_in + b_in
    c_q, c_kv, k_pe, gate_a, q_s, k_s, v_s, gate_b, mg_a, mg_b = jnp.split(z, offsets, axis=-1)
    q_mla = (_rmsnorm(c_q, qn_g) @ w_uq).reshape(B, S, MLA_HEADS, MLA_NOPE + MLA_ROPE)
    kv = (_rmsnorm(c_kv, kvn_g) @ w_ukv).reshape(B, S, MLA_HEADS, MLA_NOPE + MLA_V)
    k_nope, v_mla = kv[..., :MLA_NOPE], kv[..., MLA_NOPE:]
    q_s = q_s.reshape(B, S, SWA_KV_HEADS, SWA_GROUP, SWA_HEAD_DIM)
    k_s = k_s.reshape(B, S, SWA_KV_HEADS, SWA_HEAD_DIM)
    v_s = v_s.reshape(B, S, SWA_KV_HEADS, SWA_HEAD_DIM)
    return q_mla, k_nope, v_mla, k_pe, gate_a, q_s, k_s, v_s, gate_b, mg_a, mg_b


def _mla_keys(k_nope, k_pe):
    B, S, H, _ = k_nope.shape
    return jnp.concatenate([k_nope, jnp.broadcast_to(k_pe[:, :, None, :], (B, S, H, MLA_ROPE))], axis=-1)


def _merge(a_heads, gate_a, b_heads, gate_b, mg_a, mg_b, w_ba, w_bb, w_o):
    y_a = (a_heads * jax.nn.silu(gate_a)) @ w_ba
    y_b = (b_heads * jax.nn.silu(gate_b)) @ w_bb
    return (jax.nn.sigmoid(mg_a) * y_a + jax.nn.sigmoid(mg_b) * y_b) @ w_o


def _mla_latent(q, k, v, k_ctx, v_ctx):
    B, S, H, dq = q.shape
    scale = dq ** -0.5
    k_all = jnp.concatenate([k, k_ctx], axis=1)
    v_all = jnp.concatenate([v, v_ctx], axis=1)

    def blk(i):
        qb = lax.dynamic_slice_in_dim(q, i * BLOCK, BLOCK, axis=1)
        s = jnp.einsum('bqhd,bkhd->bhqk', qb, k_all).astype(jnp.float32) * scale
        p = jax.nn.softmax(s, axis=-1).astype(v_all.dtype)
        return jnp.einsum('bhqk,bkhd->bqhd', p, v_all)

    o = lax.map(blk, jnp.arange(S // BLOCK))
    return o.transpose(1, 0, 2, 3, 4).reshape(B, S, H * MLA_V)


def _swa_latent(q, k, v, k_ctx, v_ctx, sink_l):
    B, S, KV, G, d = q.shape
    C = k_ctx.shape[1]
    scale = d ** -0.5
    span = BLOCK + 2 * WINDOW
    pad = ((0, 0), (WINDOW, WINDOW), (0, 0), (0, 0))
    k_pad = jnp.pad(k, pad)
    v_pad = jnp.pad(v, pad)
    qi = jnp.arange(BLOCK)[:, None]
    kj = jnp.arange(span)[None, :]
    band = jnp.abs(kj - WINDOW - qi) <= WINDOW
    sink_b = jnp.broadcast_to(sink_l.astype(jnp.float32).reshape(1, KV, G, 1, 1), (B, KV, G, BLOCK, 1))

    def blk(i):
        start = i * BLOCK
        qb = lax.dynamic_slice_in_dim(q, start, BLOCK, axis=1)
        kw = lax.dynamic_slice_in_dim(k_pad, start, span, axis=1)
        vw = lax.dynamic_slice_in_dim(v_pad, start, span, axis=1)
        pos = start - WINDOW + kj
        mask = band & (pos >= 0) & (pos < S)
        s_w = jnp.einsum('bqkgd,bpkd->bkgqp', qb, kw).astype(jnp.float32) * scale
        s_w = jnp.where(mask, s_w, NEG)
        s_c = jnp.einsum('bqkgd,bckd->bkgqc', qb, k_ctx).astype(jnp.float32) * scale
        p = jax.nn.softmax(jnp.concatenate([s_w, s_c, sink_b], axis=-1), axis=-1).astype(v.dtype)
        return (jnp.einsum('bkgqp,bpkd->bqkgd', p[..., :span], vw)
                + jnp.einsum('bkgqc,bckd->bqkgd', p[..., span:span + C], v_ctx))

    o = lax.map(blk, jnp.arange(S // BLOCK))
    return o.transpose(1, 0, 2, 3, 4, 5).reshape(B, S, KV * G * d)


def _context_mixer(cx, sink_l, w_ba, w_bb, w_o):
    q, k_nope, v, k_pe, gate_a, q_s, k_s, v_s, gate_b, mg_a, mg_b = cx
    B, C = q.shape[:2]
    k = _mla_keys(k_nope, k_pe)
    s = jnp.einsum('bqhd,bkhd->bhqk', q, k).astype(jnp.float32) * (q.shape[-1] ** -0.5)
    a = jnp.einsum('bhqk,bkhd->bqhd', jax.nn.softmax(s, axis=-1).astype(v.dtype), v).reshape(B, C, MLA_WIDTH)
    s2 = jnp.einsum('bqkgd,bckd->bkgqc', q_s, k_s).astype(jnp.float32) * (SWA_HEAD_DIM ** -0.5)
    sink_b = jnp.broadcast_to(sink_l.astype(jnp.float32).reshape(1, SWA_KV_HEADS, SWA_GROUP, 1, 1),
                              s2.shape[:-1] + (1,))
    p2 = jax.nn.softmax(jnp.concatenate([s2, sink_b], axis=-1), axis=-1)[..., :C].astype(v_s.dtype)
    b = jnp.einsum('bkgqc,bckd->bqkgd', p2, v_s).reshape(B, C, SWA_WIDTH)
    return _merge(a, gate_a, b, gate_b, mg_a, mg_b, w_ba, w_bb, w_o)


def setup_inputs(seed: int = 0) -> dict:
    key = jax.random.key(seed)
    ks = jax.random.split(key, 20)
    D = D_MODEL

    def nrm(k, shape, fan_in):
        return jax.random.normal(k, shape, jnp.float32) * (fan_in ** -0.5)

    return {
        "x": jax.random.normal(ks[0], (BATCH, SEQ, D), jnp.float32),
        "c": jax.random.normal(ks[1], (BATCH, D), jnp.float32),
        "ctx": jax.random.normal(ks[2], (BATCH, CTX_LEN, D), jnp.float32),
        "c_ctx": jax.random.normal(ks[3], (D,), jnp.float32),
        "w_ada": nrm(ks[4], (DEPTH, D, 3 * D), D),
        "b_ada": 0.02 * jax.random.normal(ks[5], (DEPTH, 3 * D), jnp.float32),
        "norm_g": 1.0 + 0.02 * jax.random.normal(ks[6], (DEPTH, D), jnp.float32),
        "w_in": nrm(ks[7], (DEPTH, D, IN_WIDTH), D),
        "b_in": 0.02 * jax.random.normal(ks[8], (DEPTH, IN_WIDTH), jnp.float32),
        "q_norm_g": 1.0 + 0.02 * jax.random.normal(ks[9], (DEPTH, MLA_Q_RANK), jnp.float32),
        "kv_norm_g": 1.0 + 0.02 * jax.random.normal(ks[10], (DEPTH, MLA_KV_RANK), jnp.float32),
        "w_uq": nrm(ks[11], (DEPTH, MLA_Q_RANK, MLA_HEADS * (MLA_NOPE + MLA_ROPE)), MLA_Q_RANK),
        "w_ukv": nrm(ks[12], (DEPTH, MLA_KV_RANK, MLA_HEADS * (MLA_NOPE + MLA_V)), MLA_KV_RANK),
        "sink": jax.random.normal(ks[13], (DEPTH, SWA_HEADS), jnp.float32),
        "w_branch_a": nrm(ks[14], (DEPTH, MLA_WIDTH, D), MLA_WIDTH),
        "w_branch_b": nrm(ks[15], (DEPTH, SWA_WIDTH, D), SWA_WIDTH),
        "w_out": nrm(ks[16], (DEPTH, D, D), D),
        "final_g": 1.0 + 0.02 * jax.random.normal(ks[17], (D,), jnp.float32),
    }


def reference(x, c, ctx, c_ctx, w_ada, b_ada, norm_g, w_in, b_in, q_norm_g, kv_norm_g,
              w_uq, w_ukv, sink, w_branch_a, w_branch_b, w_out, final_g):
    B, S, D = x.shape
    ROWS = S // GRID_W
    rows = jnp.repeat(jnp.arange(ROWS, dtype=jnp.int32), GRID_W)
    cols = jnp.tile(jnp.arange(GRID_W, dtype=jnp.int32), ROWS)
    s_c = jax.nn.silu(c)
    s_cc = jax.nn.silu(c_ctx)
    for l in range(DEPTH):
        shift, scale, gate = jnp.split((s_c @ w_ada[l] + b_ada[l])[:, None, :], 3, axis=-1)
        shift_c, scale_c, gate_c = jnp.split(s_cc @ w_ada[l] + b_ada[l], 3)
        h = _rmsnorm(x, norm_g[l]) * (1 + scale) + shift
        h_c = _rmsnorm(ctx, norm_g[l]) * (1 + scale_c) + shift_c

        lat = _branch_inputs(h, w_in[l], b_in[l], q_norm_g[l], kv_norm_g[l], w_uq[l], w_ukv[l])
        cx = _branch_inputs(h_c, w_in[l], b_in[l], q_norm_g[l], kv_norm_g[l], w_uq[l], w_ukv[l])
        q_mla, k_nope, v_mla, k_pe, gate_a, q_s, k_s, v_s, gate_b, mg_a, mg_b = lat

        q_mla = jnp.concatenate([q_mla[..., :MLA_NOPE], _rope_2d(q_mla[..., MLA_NOPE:], rows, cols)], axis=-1)
        k_mla = _mla_keys(k_nope, _rope_2d(k_pe, rows, cols))
        q_s = _rope_2d(q_s, rows, cols)
        k_s = _rope_2d(k_s, rows, cols)

        k_mla_ctx = _mla_keys(cx[1], cx[3])
        a_heads = _mla_latent(q_mla, k_mla, v_mla, k_mla_ctx, cx[2])
        b_heads = _swa_latent(q_s, k_s, v_s, cx[6], cx[7], sink[l])
        out = _merge(a_heads, gate_a, b_heads, gate_b, mg_a, mg_b, w_branch_a[l], w_branch_b[l], w_out[l])
        if l + 1 < DEPTH:
            ctx = ctx + gate_c * _context_mixer(cx, sink[l], w_branch_a[l], w_branch_b[l], w_out[l])
        x = x + gate * out
    return _rmsnorm(x, final_g)
```

```cpp
#include <hip/hip_runtime.h>
#include <hip/hip_cooperative_groups.h>
#include <stdint.h>
#include <cstdio>
namespace cg = cooperative_groups;

#ifndef MULTI_LAUNCH
#define MULTI_LAUNCH 0
#endif

typedef unsigned short u16;
typedef short bf16x8 __attribute__((ext_vector_type(8)));
typedef short s16x4 __attribute__((ext_vector_type(4)));
typedef float f32x16 __attribute__((ext_vector_type(16)));
typedef float f32x4 __attribute__((ext_vector_type(4)));
typedef float f32x2 __attribute__((ext_vector_type(2)));
typedef __bf16 bf16x2n __attribute__((ext_vector_type(2)));
typedef unsigned u32x2 __attribute__((ext_vector_type(2)));
typedef unsigned u32x4 __attribute__((ext_vector_type(4)));
#define DI __device__ __forceinline__
#define MFMA(a, b, c) __builtin_amdgcn_mfma_f32_32x32x16_bf16((a), (b), (c), 0, 0, 0)

constexpr int DM = 2048, NB = 2, SEQ = 16384, CTX = 256;
constexpr int T_LAT = NB * SEQ;
constexpr int T_ALL = T_LAT + NB * CTX;
constexpr int KEYS = SEQ + CTX;
constexpr int NIN = 8960;
constexpr float EPSN = 1e-6f;
constexpr float LOG2E = 1.4426950408889634f;

DI int in_src_col(int n) { return n < 1024 ? n : (n < 8704 ? n + 64 : n - 7680); }

constexpr size_t al256(size_t x) { return (x + 255) / 256 * 256; }
constexpr size_t OFF_MOD = 0;
constexpr size_t OFF_ROPE = al256(OFF_MOD + 3 * 6144 * 4);
constexpr size_t OFF_ROWSS = al256(OFF_ROPE + 256 * 16 * 8);
constexpr size_t OFF_BIAS = al256(OFF_ROWSS + (size_t)T_LAT * 4);
constexpr size_t OFF_WIN = al256(OFF_BIAS + NIN * 4);
constexpr size_t OFF_WUQ = al256(OFF_WIN + (size_t)NIN * 2048 * 2);
constexpr size_t OFF_WUKV = al256(OFF_WUQ + (size_t)1536 * 512 * 2);
constexpr size_t OFF_WBA = al256(OFF_WUKV + (size_t)2048 * 512 * 2);
constexpr size_t OFF_WBB = al256(OFF_WBA + (size_t)2048 * 1024 * 2);
constexpr size_t OFF_WO = al256(OFF_WBB + (size_t)2048 * 1024 * 2);
constexpr size_t OFF_H = al256(OFF_WO + (size_t)2048 * 2048 * 2);
constexpr size_t OFF_M = OFF_H;
constexpr size_t OFF_CQ = al256(OFF_H + (size_t)T_ALL * 2048 * 2);
constexpr size_t OFF_CKV = OFF_CQ + (size_t)T_LAT * 512 * 2;
constexpr size_t OFF_GA = OFF_CQ;
constexpr size_t OFF_KPE = al256(OFF_CKV + (size_t)T_ALL * 512 * 2);
constexpr size_t OFF_SGA = al256(OFF_KPE + (size_t)NB * KEYS * 64 * 2);
constexpr size_t OFF_SGB = al256(OFF_SGA + (size_t)T_LAT * 1024 * 2);
constexpr size_t OFF_QS = al256(OFF_SGB + (size_t)T_LAT * 1024 * 2);
constexpr size_t OFF_KS = al256(OFF_QS + (size_t)T_LAT * 1024 * 2);
constexpr size_t OFF_VST = al256(OFF_KS + (size_t)NB * KEYS * 256 * 2);
constexpr size_t OFF_MGA = al256(OFF_VST + (size_t)NB * 4 * 64 * KEYS * 2);
constexpr size_t OFF_MGB = al256(OFF_MGA + (size_t)T_LAT * 2048 * 2);
constexpr size_t OFF_DLT = OFF_MGA;
constexpr size_t OFF_Q = al256(OFF_MGB + (size_t)T_LAT * 2048 * 2);
constexpr size_t OFF_KN = al256(OFF_Q + (size_t)T_LAT * 1536 * 2);
constexpr size_t OFF_VT = al256(OFF_KN + (size_t)NB * KEYS * 1024 * 2);
constexpr size_t OFF_GB = al256(OFF_VT + (size_t)NB * 8 * 128 * KEYS * 2);
constexpr size_t WS_END = al256(OFF_GB + (size_t)T_LAT * 1024 * 2);
static_assert(WS_END <= (size_t)4 * T_LAT * DM * 4, "workspace too big");
static_assert((size_t)T_LAT * 1024 * 2 <= (size_t)T_LAT * 512 * 2 + (size_t)T_ALL * 512 * 2, "ga alias");

struct Params {
  const float *x, *c, *ctx, *c_ctx, *w_ada, *b_ada, *norm_g, *w_in, *b_in, *qn_g, *kvn_g, *w_uq, *w_ukv, *sink, *w_ba, *w_bb, *w_o, *final_g;
  float* out;
  char* ws;
};

DI unsigned pk2(float a, float b) { f32x2 v = {a, b}; bf16x2n r = __builtin_convertvector(v, bf16x2n); return __builtin_bit_cast(unsigned, r); }
DI u16 f2bf(float a) { return (u16)(pk2(a, 0.f) & 0xffffu); }
typedef int i32x8 __attribute__((ext_vector_type(8)));
typedef unsigned char u8;
DI unsigned pk4f8(float a, float b, float c, float d) { int w = 0; w = __builtin_amdgcn_cvt_pk_fp8_f32(a, b, w, false); w = __builtin_amdgcn_cvt_pk_fp8_f32(c, d, w, true); return (unsigned)w; }
typedef short s16x2 __attribute__((ext_vector_type(2)));
DI unsigned pk4f8s(float a, float b, float c, float d, float sc) {
  s16x2 w = {0, 0};
  w = __builtin_amdgcn_cvt_scalef32_pk_fp8_f32(w, a, b, sc, false);
  w = __builtin_amdgcn_cvt_scalef32_pk_fp8_f32(w, c, d, sc, true);
  return __builtin_bit_cast(unsigned, w);
}
DI u8 f2f8(float a) { return (u8)(__builtin_amdgcn_cvt_pk_fp8_f32(a, a, 0, false) & 0xff); }
#define MFMA8(a, b, c) __builtin_amdgcn_mfma_scale_f32_32x32x64_f8f6f4((a), (b), (c), 0, 0, 0, 0, 0, 0)
DI float bf2f(u16 v) { return __uint_as_float(((unsigned)v) << 16); }
DI int opaque_tid() { int t = threadIdx.x; asm volatile("" : "+v"(t)); return t; }
DI int tperm(int t) {
  if (gridDim.x != 256) return t;
  const int b = t & 255, x = b & 7, slot = b >> 3;
  return (t & ~255) | ((8 * (x >> 2) + (slot >> 2)) * 16 + 4 * (x & 3) + (slot & 3));
}
DI int crow(int r, int hi) { return (r & 3) + 8 * (r >> 2) + 4 * hi; }
DI float siluf(float x) { return x * __builtin_amdgcn_rcpf(1.f + __expf(-x)); }
DI float sigmf(float x) { return __builtin_amdgcn_rcpf(1.f + __expf(-x)); }
DI void bkey(int m, int& b, int& key) {
  if (m < T_LAT) { b = m >> 14; key = m & (SEQ - 1); }
  else { int u = m - T_LAT; b = u >> 8; key = SEQ + (u & 255); }
}
DI float xhalf_max(float v) {
  auto rr = __builtin_amdgcn_permlane32_swap(__float_as_uint(v), __float_as_uint(v), false, false);
  return fmaxf(__uint_as_float(rr[0]), __uint_as_float(rr[1]));
}
DI float xhalf_sum(float v) {
  auto rr = __builtin_amdgcn_permlane32_swap(__float_as_uint(v), __float_as_uint(v), false, false);
  return __uint_as_float(rr[0]) + __uint_as_float(rr[1]);
}

constexpr int P4_SWA_N = NB * 4 * 256;
constexpr int P4_MLA_N = NB * 8 * 64;
constexpr int BM = 256, BN = 256, BK = 64;
constexpr int LDS_A = BM * BK * 2, LDS_B = BN * BK * 2, LDS_STAGE = LDS_A + LDS_B;
constexpr int LDS_GEMM = 2 * LDS_STAGE;
constexpr int LDS_BYTES = 9 * 16384;

template <bool PP = true, bool PIN = true>
DI void gemm_mainloop(f32x16 (&acc)[4][2], const u16* __restrict__ A, long lda, const u16* __restrict__ Bt, long ldb, int nk, char* lds) {
  const int t = opaque_tid(), lane = t & 63, wid = t >> 6, r32 = lane & 31, hi = lane >> 5;
  const int wm = wid >> 2, wn = wid & 3;
  const int lrow = t >> 3, lch = t & 7;
  const u16* ag = A + (long)lrow * lda + lch * 8;
  const u16* bg = Bt + (long)lrow * ldb + lch * 8;
  const int wofs = lrow * 128 + ((lch ^ ((lrow >> 1) & 7)) << 4);
  bf16x8 ra[4], rb[4];
#define GLOAD(KT) do { const u16* ag2 = ag + (KT) * BK; const u16* bg2 = bg + (KT) * BK;                             \
    _Pragma("unroll") for (int pp = 0; pp < 4; ++pp) ra[pp] = *(const bf16x8*)(ag2 + (long)(64 * pp) * lda);      \
    _Pragma("unroll") for (int pp = 0; pp < 4; ++pp) rb[pp] = *(const bf16x8*)(bg2 + (long)(64 * pp) * ldb); } while (0)
#define LSTORE(ST) do { char* da = lds + (ST) * LDS_STAGE;                                                           \
    _Pragma("unroll") for (int pp = 0; pp < 4; ++pp) *(bf16x8*)(da + wofs + pp * 8192) = ra[pp];                   \
    _Pragma("unroll") for (int pp = 0; pp < 4; ++pp) *(bf16x8*)(da + LDS_A + wofs + pp * 8192) = rb[pp]; } while (0)
  const int xr = (r32 >> 1) & 7;
  const int arow0 = (wm * 128 + r32) * 128, brow0 = (wn * 64 + r32) * 128;
  GLOAD(0);
  LSTORE(0);
  if (PP && nk > 1) GLOAD(1);
  __syncthreads();
  for (int kt = 0; kt < nk; ++kt) {
    const char* sa = lds + (kt & 1) * LDS_STAGE;
    const char* sb = sa + LDS_A;
    char* da = lds + ((kt + 1) & 1) * LDS_STAGE;
    const bool more = kt + 1 < nk, more2 = kt + 2 < nk;
    if (!PP && more) GLOAD(kt + 1);
    bf16x8 fa[4], fb[2], na[4], nb[2];
    {
      const int co = ((hi ^ xr) << 4);
      fb[0] = *(const bf16x8*)(sb + brow0 + co); fb[1] = *(const bf16x8*)(sb + brow0 + 32 * 128 + co);
#pragma unroll
      for (int mi = 0; mi < 4; ++mi) fa[mi] = *(const bf16x8*)(sa + arow0 + mi * 32 * 128 + co);
    }
#pragma unroll
    for (int s = 0; s < 4; ++s) {
      if (s < 3) {
        const int co = (((2 * (s + 1) + hi) ^ xr) << 4);
        nb[0] = *(const bf16x8*)(sb + brow0 + co); nb[1] = *(const bf16x8*)(sb + brow0 + 32 * 128 + co);
#pragma unroll
        for (int mi = 0; mi < 4; ++mi) na[mi] = *(const bf16x8*)(sa + arow0 + mi * 32 * 128 + co);
      }
      if (PIN) __builtin_amdgcn_sched_barrier(0);
#pragma unroll
      for (int mi = 0; mi < 4; ++mi) {
        acc[mi][0] = MFMA(fa[mi], fb[0], acc[mi][0]);
        acc[mi][1] = MFMA(fa[mi], fb[1], acc[mi][1]);
      }
      if (PP && more) {
        *(bf16x8*)(da + wofs + s * 8192) = ra[s];
        *(bf16x8*)(da + LDS_A + wofs + s * 8192) = rb[s];
        if (more2) {
          ra[s] = *(const bf16x8*)(ag + (kt + 2) * BK + (long)(64 * s) * lda);
          rb[s] = *(const bf16x8*)(bg + (kt + 2) * BK + (long)(64 * s) * ldb);
        }
      }
      if (PIN) __builtin_amdgcn_sched_barrier(0);
      if (s < 3) {
#pragma unroll
        for (int mi = 0; mi < 4; ++mi) fa[mi] = na[mi];
        fb[0] = nb[0]; fb[1] = nb[1];
      }
    }
    if (!PP && more) LSTORE((kt + 1) & 1);
    __syncthreads();
  }
#undef GLOAD
#undef LSTORE
}
DI void zero_acc(f32x16 (&acc)[4][2]) {
#pragma unroll
  for (int i = 0; i < 4; ++i)
#pragma unroll
    for (int j = 0; j < 2; ++j)
#pragma unroll
      for (int r = 0; r < 16; ++r) acc[i][j][r] = 0.f;
}

DI void p0_adaln(const Params& p, int item, char* lds) {
  float* sil = (float*)lds;
  float* red = (float*)(lds + 24576);
  const int t = opaque_tid();
  for (int i = t; i < 3 * 2048; i += 512) {
    int v = i >> 11, k = i & 2047;
    float cv = v < 2 ? p.c[v * 2048 + k] : p.c_ctx[k];
    sil[i] = siluf(cv);
  }
  __syncthreads();
  const int n0 = item * 64, cgp = t & 15, kl = t >> 4;
  f32x4 a0 = {0, 0, 0, 0}, a1 = a0, a2 = a0;
  const float* wp = p.w_ada + n0 + cgp * 4;
#pragma unroll 8
  for (int k = kl; k < 2048; k += 32) {
    f32x4 w = *(const f32x4*)(wp + (long)k * 6144);
    a0 += w * sil[k]; a1 += w * sil[2048 + k]; a2 += w * sil[4096 + k];
  }
#pragma unroll
  for (int i = 0; i < 4; ++i) {
    red[(kl * 3 + 0) * 64 + cgp * 4 + i] = a0[i];
    red[(kl * 3 + 1) * 64 + cgp * 4 + i] = a1[i];
    red[(kl * 3 + 2) * 64 + cgp * 4 + i] = a2[i];
  }
  __syncthreads();
  if (t < 192) {
    int v = t >> 6, col = t & 63;
    float s = 0.f;
    for (int k = 0; k < 32; ++k) s += red[(k * 3 + v) * 64 + col];
    float* mod = (float*)(p.ws + OFF_MOD);
    mod[v * 6144 + n0 + col] = s + p.b_ada[n0 + col];
  }
  __syncthreads();
}
DI void p0_rope(const Params& p) {
  f32x2* tab = (f32x2*)(p.ws + OFF_ROPE);
  const int t = threadIdx.x;
  for (int e = 0; e < 8; ++e) {
    int idx = t * 8 + e, pos = idx >> 4, j = idx & 15;
    float inv = exp2f(-(float)j * (13.287712379549449f / 16.f));
    float ang = (float)pos * inv;
    float kk = rintf(ang * 0.15915494309189535f);
    double rd = (double)ang - (double)kk * 6.283185307179586;
    float r = (float)rd;
    f32x2 cs = {cosf(r), sinf(r)};
    tab[idx] = cs;
  }
}
DI void p0_zero(const Params& p) {
  float* rs = (float*)(p.ws + OFF_ROWSS);
  for (int i = threadIdx.x; i < T_LAT; i += 512) rs[i] = 0.f;
}
DI void p0_transpose(const float* __restrict__ src, long lds_src, int k0, u16* __restrict__ dst, long ldd, int n0,
                     const float* __restrict__ g, bool is_win, char* lds) {
  float (*tile)[257] = (float (*)[257])lds;
  const int t = opaque_tid();
  f32x4 v[8];
#pragma unroll
  for (int pp = 0; pp < 8; ++pp) {
    const int idx = t + 512 * pp, kr = idx >> 6, col = (idx & 63) * 4;
    const int nb = n0 + (col & ~63);
    const bool zero = is_win && nb >= 8768;
    const int sc = (is_win ? in_src_col(nb) : nb) + (col & 63);
    v[pp] = f32x4{0, 0, 0, 0};
    if (!zero) v[pp] = *(const f32x4*)(src + (long)(k0 + kr) * lds_src + sc);
  }
#pragma unroll
  for (int pp = 0; pp < 8; ++pp) {
    const int idx = t + 512 * pp, kr = idx >> 6, col = (idx & 63) * 4;
    f32x4 w = v[pp];
    if (g) w *= g[k0 + kr];
    tile[kr][col + 0] = w[0]; tile[kr][col + 1] = w[1]; tile[kr][col + 2] = w[2]; tile[kr][col + 3] = w[3];
  }
  __syncthreads();
#pragma unroll
  for (int q = 0; q < 4; ++q) {
    const int o = t + 512 * q, n = o >> 3, kc = o & 7;
    u32x4 ov;
    ov[0] = pk2(tile[kc * 8 + 0][n], tile[kc * 8 + 1][n]);
    ov[1] = pk2(tile[kc * 8 + 2][n], tile[kc * 8 + 3][n]);
    ov[2] = pk2(tile[kc * 8 + 4][n], tile[kc * 8 + 5][n]);
    ov[3] = pk2(tile[kc * 8 + 6][n], tile[kc * 8 + 7][n]);
    *(u32x4*)(dst + (long)(n0 + n) * ldd + k0 + kc * 8) = ov;
  }
  __syncthreads();
}
constexpr int P0_ADA = 96, P0_MISC = 1;
constexpr int P0_WIN = 35 * 32, P0_WUQ = 6 * 8, P0_WUKV = 8 * 8, P0_WB = 8 * 16, P0_WO = 8 * 32;
constexpr int P0_TOTAL = P0_ADA + P0_MISC + P0_WIN + P0_WUQ + P0_WUKV + 2 * P0_WB + P0_WO;
DI void phase0(const Params& p, char* lds) {
  for (int it = blockIdx.x; it < P0_TOTAL; it += gridDim.x) {
    int i = it;
    if (i < P0_ADA) { p0_adaln(p, i, lds); continue; }
    i -= P0_ADA;
    if (i == 0) { p0_rope(p); continue; }
    i -= P0_MISC;
    if (i < P0_WIN) {
      const int ntile = i >> 5, ktile = i & 31, n0 = ntile * 256;
      if (ktile == 0 && threadIdx.x < 256) {
        const int n = n0 + threadIdx.x;
        ((float*)(p.ws + OFF_BIAS))[n] = n >= 8768 ? 0.f : p.b_in[in_src_col(n)];
      }
      p0_transpose(p.w_in, 8768, ktile * 64, (u16*)(p.ws + OFF_WIN), 2048, n0, nullptr, true, lds);
      continue;
    }
    i -= P0_WIN;
    if (i < P0_WUQ) { const int ntile = i >> 3, ktile = i & 7; p0_transpose(p.w_uq, 1536, ktile * 64, (u16*)(p.ws + OFF_WUQ), 512, ntile * 256, p.qn_g, false, lds); continue; }
    i -= P0_WUQ;
    if (i < P0_WUKV) { const int ntile = i >> 3, ktile = i & 7; p0_transpose(p.w_ukv, 2048, ktile * 64, (u16*)(p.ws + OFF_WUKV), 512, ntile * 256, p.kvn_g, false, lds); continue; }
    i -= P0_WUKV;
    if (i < P0_WB) { const int ntile = i >> 4, ktile = i & 15; p0_transpose(p.w_ba, 2048, ktile * 64, (u16*)(p.ws + OFF_WBA), 1024, ntile * 256, nullptr, false, lds); continue; }
    i -= P0_WB;
    if (i < P0_WB) { const int ntile = i >> 4, ktile = i & 15; p0_transpose(p.w_bb, 2048, ktile * 64, (u16*)(p.ws + OFF_WBB), 1024, ntile * 256, nullptr, false, lds); continue; }
    i -= P0_WB;
    { const int ntile = i >> 5, ktile = i & 31; p0_transpose(p.w_o, 2048, ktile * 64, (u16*)(p.ws + OFF_WO), 2048, ntile * 256, nullptr, false, lds); }
  }
}

DI void phase1(const Params& p) {
  const int lane = threadIdx.x & 63, wid = threadIdx.x >> 6;
  const float* mod = (const float*)(p.ws + OFF_MOD);
  u16* h = (u16*)(p.ws + OFF_H);
  const int stride = gridDim.x * 8;
  int row = blockIdx.x * 8 + wid;
  f32x4 xv[8], xn[8];
  if (row < T_ALL) {
    const float* xr = row < T_LAT ? p.x + (long)row * DM : p.ctx + (long)(row - T_LAT) * DM;
#pragma unroll
    for (int i = 0; i < 8; ++i) xv[i] = *(const f32x4*)(xr + (i * 64 + lane) * 4);
  }
  for (; row < T_ALL; row += stride) {
    const int nrow = row + stride;
    if (nrow < T_ALL) {
      const float* xr = nrow < T_LAT ? p.x + (long)nrow * DM : p.ctx + (long)(nrow - T_LAT) * DM;
#pragma unroll
      for (int i = 0; i < 8; ++i) xn[i] = *(const f32x4*)(xr + (i * 64 + lane) * 4);
    }
    const int v = row < T_LAT ? (row >> 14) : 2;
    float ss = 0.f;
#pragma unroll
    for (int i = 0; i < 8; ++i) ss += xv[i][0] * xv[i][0] + xv[i][1] * xv[i][1] + xv[i][2] * xv[i][2] + xv[i][3] * xv[i][3];
#pragma unroll
    for (int o = 1; o < 64; o <<= 1) ss += __shfl_xor(ss, o);
    const float rstd = rsqrtf(ss * (1.f / DM) + EPSN);
#pragma unroll
    for (int i = 0; i < 8; ++i) {
      const int col = (i * 64 + lane) * 4;
      f32x4 g = *(const f32x4*)(p.norm_g + col);
      f32x4 sh = *(const f32x4*)(mod + v * 6144 + col);
      f32x4 sc = *(const f32x4*)(mod + v * 6144 + 2048 + col);
      f32x4 y = (xv[i] * rstd) * g * (sc + 1.f) + sh;
      u32x2 o = {pk2(y[0], y[1]), pk2(y[2], y[3])};
      *(u32x2*)(h + (long)row * DM + col) = o;
    }
#pragma unroll
    for (int i = 0; i < 8; ++i) xv[i] = xn[i];
  }
}

DI void store_rows(u16* __restrict__ dst, long ld, long row0, int col, const f32x16& v) {
  const bool odd = col & 1;
  u16* base = dst + (row0 + (odd ? 1 : 0)) * ld + (col & ~1);
#pragma unroll
  for (int q = 0; q < 8; ++q) {
    const float ve = v[2 * q], vo = v[2 * q + 1];
    const float send = odd ? ve : vo;
    const float got = __int_as_float(__builtin_amdgcn_update_dpp(0, __float_as_int(send), 0xB1, 0xF, 0xF, true));
    const unsigned pk = odd ? pk2(got, vo) : pk2(ve, got);
    *(unsigned*)(base + (long)((2 * q & 3) + 8 * (q >> 1)) * ld) = pk;
  }
}
DI void store_rows8(u8* __restrict__ dst, long ld, long row0, int col, const f32x16& v) {
#pragma unroll
  for (int r = 0; r < 16; ++r) dst[(row0 + (r & 3) + 8 * (r >> 2)) * ld + col] = f2f8(v[r]);
}
DI void inproj_epilogue(const Params& p, f32x16 (&acc)[4][2], int mt, int nt256) {
  const int tid_ = opaque_tid();
  const int lane = tid_ & 63, wid = tid_ >> 6, r32 = lane & 31, hi = lane >> 5, wm = wid >> 2, wn = wid & 3;
  const int m0 = mt * 256 + wm * 128, n0 = nt256 * 256 + wn * 64;
  const int nt = n0 >> 7;
  const bool lat = mt < 128;
  const int type = nt < 4 ? 0 : nt < 8 ? 1 : nt < 16 ? 2 : nt < 24 ? 3 : nt < 26 ? 4 : nt < 28 ? 5 : nt < 36 ? 6 : nt < 52 ? 7 : nt < 68 ? 8 : 9;
  if (n0 >= 8768) return;
  if (!lat && !(type == 1 || type == 4 || type == 5 || type == 9)) return;
  const float* bias = (const float*)(p.ws + OFF_BIAS);
  const f32x2* rope = (const f32x2*)(p.ws + OFF_ROPE);
#pragma unroll
  for (int ni = 0; ni < 2; ++ni) {
    const int n = n0 + ni * 32 + r32;
    const float bv = bias[n];
#pragma unroll
    for (int mi = 0; mi < 4; ++mi) {
      f32x16 z = acc[mi][ni] + bv;
      const int mb = m0 + mi * 32 + 4 * hi;
      if (type == 3 || ((type == 4 || type == 9) && lat)) {
#pragma unroll
        for (int r = 0; r < 16; ++r) {
          const int m = mb + (r & 3) + 8 * (r >> 2);
          const int s = m & (SEQ - 1);
          const int pos = ni == 0 ? (s >> 6) : (s & 63);
          const f32x2 cs = rope[pos * 16 + (r32 & 15)];
          const float pr = __shfl_xor(z[r], 16);
          z[r] = (r32 & 16) ? z[r] * cs[0] + pr * cs[1] : z[r] * cs[0] - pr * cs[1];
        }
      }
      if (type == 0) { store_rows((u16*)(p.ws + OFF_CQ), 512, mb, n, z); }
      else if (type == 1) { store_rows((u16*)(p.ws + OFF_CKV), 512, mb, n - 512, z); }
      else if (type == 2 || type == 6) {
#pragma unroll
        for (int r = 0; r < 16; ++r) z[r] = siluf(z[r]);
        store_rows((u16*)(p.ws + (type == 2 ? OFF_SGA : OFF_SGB)), 1024, mb, n - (type == 2 ? 1024 : 3584), z);
      } else if (type == 3) {
        z *= (0.125f * LOG2E);
        store_rows((u16*)(p.ws + OFF_QS), 1024, mb, n - 2048, z);
      } else if (type == 4 || type == 9) {
        int b, key; bkey(mb, b, key);
        const long kr = (long)b * KEYS + key;
        if (type == 4) store_rows((u16*)(p.ws + OFF_KS), 256, kr, n - 3072, z);
        else store_rows8((u8*)(p.ws + OFF_KPE), 64, kr, n - 8704, z);
      } else if (type == 5) {
        const int nn = n - 3328, kvh = nn >> 6, dv = nn & 63;
        int b, key; bkey(mb, b, key);
        u16* vst = (u16*)(p.ws + OFF_VST) + ((long)(b * 4 + kvh) * 64 + dv) * KEYS + key;
#pragma unroll
        for (int g4 = 0; g4 < 4; ++g4) {
          u32x2 o = {pk2(z[4 * g4], z[4 * g4 + 1]), pk2(z[4 * g4 + 2], z[4 * g4 + 3])};
          *(u32x2*)(vst + 8 * g4) = o;
        }
      } else {
#pragma unroll
        for (int r = 0; r < 16; ++r) z[r] = sigmf(z[r]);
        const int ntm = nt256 - (type == 7 ? 18 : 26);
        u16* fp = (u16*)(p.ws + (type == 7 ? OFF_MGA : OFF_MGB)) + ((((long)(mt * 8 + ntm) * 8 + wid) * 4 + mi) * 2 + ni) * 1024 + lane * 16;
        u32x4 o0 = {pk2(z[0], z[1]), pk2(z[2], z[3]), pk2(z[4], z[5]), pk2(z[6], z[7])};
        u32x4 o1 = {pk2(z[8], z[9]), pk2(z[10], z[11]), pk2(z[12], z[13]), pk2(z[14], z[15])};
        *(u32x4*)fp = o0; *(u32x4*)(fp + 8) = o1;
      }
    }
  }
}
constexpr int P2_LAT = 128 * 35, P2_TOTAL = P2_LAT + 10;
DI void phase2(const Params& p, char* lds) {
  const u16* h = (const u16*)(p.ws + OFF_H);
  const u16* w = (const u16*)(p.ws + OFF_WIN);
  for (int t = blockIdx.x; t < P2_TOTAL; t += gridDim.x) {
    int mt, nt;
    if (t < P2_LAT) { const int tp = (t < (P2_LAT & ~255)) ? tperm(t) : t; int g = tp / (16 * 35), wv = tp % (16 * 35); mt = g * 16 + (wv & 15); nt = wv >> 4; }
    else { int u = t - P2_LAT; mt = 128 + (u & 1); int idx = u >> 1; nt = idx < 2 ? 2 + idx : idx < 4 ? 10 + idx : 34; }
    f32x16 acc[4][2]; zero_acc(acc);
    gemm_mainloop(acc, h + (long)mt * 256 * 2048, 2048, w + (long)nt * 256 * 2048, 2048, 32, lds);
    inproj_epilogue(p, acc, mt, nt);
  }
}

DI void row_rstd(const u16* __restrict__ cbase, char* lds) {
  float* rs = (float*)(lds + LDS_GEMM);
  const int tid_ = opaque_tid();
  const int lane = tid_ & 63, wid = tid_ >> 6;
  const int sub = lane >> 4, l16 = lane & 15;
#pragma unroll
  for (int ps = 0; ps < 8; ++ps) {
    const int row = wid * 32 + ps * 4 + sub;
    const u16* rp = cbase + (long)row * 512 + l16 * 8;
    float ss = 0.f;
#pragma unroll
    for (int q = 0; q < 4; ++q) {
      bf16x8 v = *(const bf16x8*)(rp + q * 128);
#pragma unroll
      for (int e = 0; e < 8; ++e) { float f = bf2f((u16)v[e]); ss += f * f; }
    }
    ss += __shfl_xor(ss, 1); ss += __shfl_xor(ss, 2); ss += __shfl_xor(ss, 4); ss += __shfl_xor(ss, 8);
    if (l16 == 0) rs[row] = rsqrtf(ss * (1.f / 512.f) + EPSN);
  }
}
constexpr float QSCALE = 0.07216878364870323f * LOG2E;
constexpr int P3_Q = 128 * 6, P3_KV = 128 * 8, P3_TOTAL = P3_Q + P3_KV + 16;
DI void phase3(const Params& p, char* lds) {
  const float* rs = (const float*)(lds + LDS_GEMM);
  const f32x2* rope = (const f32x2*)(p.ws + OFF_ROPE);
  for (int t = blockIdx.x; t < P3_TOTAL; t += gridDim.x) {
    const int tid_ = opaque_tid();
    const int lane = tid_ & 63, wid = tid_ >> 6, r32 = lane & 31, hi = lane >> 5, wm = wid >> 2, wn = wid & 3;
    f32x16 acc[4][2]; zero_acc(acc);
    if (t < P3_Q) {
      const int tp = tperm(t); const int g = tp / (16 * 6), wv = tp % (16 * 6), mt = g * 16 + (wv & 15), nt = wv >> 4;
      const u16* A = (const u16*)(p.ws + OFF_CQ) + (long)mt * 256 * 512;
      row_rstd(A, lds);
      gemm_mainloop<true, false>(acc, A, 512, (const u16*)(p.ws + OFF_WUQ) + (long)nt * 256 * 512, 512, 8, lds);
      u8* Q = (u8*)(p.ws + OFF_Q);
#pragma unroll
      for (int mi = 0; mi < 4; ++mi) {
        const int lrow = wm * 128 + mi * 32 + 4 * hi;
        const int mb = mt * 256 + lrow;
        float rsv[16];
#pragma unroll
        for (int r = 0; r < 16; ++r) rsv[r] = rs[lrow + (r & 3) + 8 * (r >> 2)];
#pragma unroll
        for (int ni = 0; ni < 2; ++ni) {
          const int n = nt * 256 + wn * 64 + ni * 32 + r32;
          const int c6 = (nt * 8 + wn * 2 + ni) % 6;
          f32x16 z = acc[mi][ni];
#pragma unroll
          for (int r = 0; r < 16; ++r) z[r] *= rsv[r];
          if (c6 >= 4) {
#pragma unroll
            for (int r = 0; r < 16; ++r) {
              const int s = (mb + (r & 3) + 8 * (r >> 2)) & (SEQ - 1);
              const int pos = c6 == 4 ? (s >> 6) : (s & 63);
              const f32x2 cs = rope[pos * 16 + (r32 & 15)];
              const float pr = __shfl_xor(z[r], 16);
              z[r] = (r32 & 16) ? z[r] * cs[0] + pr * cs[1] : z[r] * cs[0] - pr * cs[1];
            }
          }
          z *= QSCALE;
          store_rows8(Q, 1536, mb, n, z);
        }
        asm volatile("" ::: "memory"); __builtin_amdgcn_sched_barrier(0);
      }
    } else {
      int u = t - P3_Q, mt, nt;
      if (u < P3_KV) { const int up = tperm(u); const int g = up / 128, wv = up % 128; mt = g * 16 + (wv & 15); nt = wv >> 4; }
      else { u -= P3_KV; mt = 128 + (u & 1); nt = u >> 1; }
      const u16* A = (const u16*)(p.ws + OFF_CKV) + (long)mt * 256 * 512;
      row_rstd(A, lds);
      gemm_mainloop<true, false>(acc, A, 512, (const u16*)(p.ws + OFF_WUKV) + (long)nt * 256 * 512, 512, 8, lds);
      const int hh = nt;
      const bool isv = wn >> 1;
#pragma unroll
      for (int mi = 0; mi < 4; ++mi) {
        const int lrow = wm * 128 + mi * 32 + 4 * hi;
        const int mb = mt * 256 + lrow;
        float rsv[16];
#pragma unroll
        for (int r = 0; r < 16; ++r) rsv[r] = rs[lrow + (r & 3) + 8 * (r >> 2)];
        int b, key; bkey(mb, b, key);
#pragma unroll
        for (int ni = 0; ni < 2; ++ni) {
          const int c = (wn & 1) * 64 + ni * 32 + r32;
          f32x16 z = acc[mi][ni];
#pragma unroll
          for (int r = 0; r < 16; ++r) z[r] *= rsv[r];
          if (!isv) {
            store_rows8((u8*)(p.ws + OFF_KN), 1024, (long)b * KEYS + key, hh * 128 + c, z);
          } else {
            u8* vt = (u8*)(p.ws + OFF_VT) + ((long)(b * 8 + hh) * 128 + c) * KEYS;
#pragma unroll
            for (int g4 = 0; g4 < 4; ++g4) {
              const int k0 = key + 8 * g4, w = k0 & 63;
              const int pos = (k0 & ~63) + 32 * ((w >> 2) & 1) + 4 * ((w >> 3) & 3) + 16 * (w >> 5);
              *(unsigned*)(vt + pos) = pk4f8(z[4 * g4], z[4 * g4 + 1], z[4 * g4 + 2], z[4 * g4 + 3]);
            }
          }
        }
        asm volatile("" ::: "memory"); __builtin_amdgcn_sched_barrier(0);
      }
    }
    __syncthreads();
  }
}

template <bool MLA>
DI void attn_item(const Params& p, int item, char* lds) {
  constexpr int DQK = MLA ? 192 : 64, KS = DQK / 16, DV = MLA ? 128 : 64, NDB = DV / 32;
  constexpr int KPITCH = DQK * 2, KT_BYTES = 64 * KPITCH, VT_BYTES = DV * 128, BUF = KT_BYTES + VT_BYTES;
  const int t = opaque_tid(), lane = t & 63, wid = t >> 6, r32 = lane & 31, hi = lane >> 5;
  int b, hh, q0, qrow, kvh = 0;
  if (MLA) { const int qb = item & 63, bh = item >> 6; hh = bh & 7; b = bh >> 3; q0 = qb * 256; qrow = q0 + wid * 32 + r32; }
  else { const int qb = item & 255, bk = item >> 8; kvh = bk & 3; b = bk >> 2; hh = kvh * 4 + (wid >> 1); q0 = qb * 64; qrow = q0 + (wid & 1) * 32 + r32; }
  const long tok = (long)b * SEQ + qrow;
  int wlo = 0, nw = 0, NT;
  if (MLA) NT = KEYS / 64;
  else { wlo = q0 - 128 < 0 ? 0 : q0 - 128; int whi = q0 + 192 > SEQ ? SEQ : q0 + 192; nw = (whi - wlo) >> 6; NT = nw + 4; }
  auto kstart = [&](int j) -> int { if (MLA) return j * 64; return j < nw ? wlo + j * 64 : SEQ + (j - nw) * 64; };
  bf16x8 qf[KS];
  {
    const u16* qp = MLA ? (const u16*)(p.ws + OFF_Q) + tok * 1536 + hh * 192 + hi * 8 : (const u16*)(p.ws + OFF_QS) + tok * 1024 + hh * 64 + hi * 8;
#pragma unroll
    for (int s = 0; s < KS; ++s) qf[s] = *(const bf16x8*)(qp + s * 16);
  }
  const u16* kn_g; const u16* kp_g = nullptr; const u16* vt_g;
  int kn_l, kp_l = 0, vt_l; bool vswap;
  if (MLA) {
    const int kr = t >> 4, ch = t & 15;
    kn_g = (const u16*)(p.ws + OFF_KN) + ((long)b * KEYS + kr) * 1024 + hh * 128 + ch * 8;
    kn_l = kr * KPITCH + ((ch ^ ((kr >> 1) & 7)) << 4);
    const int pr = t >> 3, pc = t & 7;
    kp_g = (const u16*)(p.ws + OFF_KPE) + ((long)b * KEYS + pr) * 64 + pc * 8;
    kp_l = pr * KPITCH + 256 + ((pc ^ ((pr >> 1) & 7)) << 4);
    const int dv = t >> 3, c16 = t & 7;
    vt_g = (const u16*)(p.ws + OFF_VT) + ((long)(b * 8 + hh) * 128 + dv) * KEYS + c16 * 8;
    vt_l = dv * 128 + ((c16 ^ ((dv >> 1) & 7)) << 4);
    vswap = dv & 16;
  } else {
    const int kr = t >> 3, ch = t & 7;
    kn_g = (const u16*)(p.ws + OFF_KS) + ((long)b * KEYS + kr) * 256 + kvh * 64 + ch * 8;
    kn_l = kr * KPITCH + ((ch ^ ((kr >> 1) & 7)) << 4);
    const int dv = t >> 3, c16 = t & 7;
    vt_g = (const u16*)(p.ws + OFF_VST) + ((long)(b * 4 + kvh) * 64 + dv) * KEYS + c16 * 8;
    vt_l = dv * 128 + ((c16 ^ ((dv >> 1) & 7)) << 4);
    vswap = dv & 16;
  }
  bf16x8 sk0, sk1, skp, sv0, sv1;
  auto gload = [&](int k0) {
    if (MLA) {
      sk0 = *(const bf16x8*)(kn_g + (long)k0 * 1024);
      sk1 = *(const bf16x8*)(kn_g + (long)(k0 + 32) * 1024);
      skp = *(const bf16x8*)(kp_g + (long)k0 * 64);
      sv0 = *(const bf16x8*)(vt_g + k0);
      sv1 = *(const bf16x8*)(vt_g + (long)64 * KEYS + k0);
    } else {
      sk0 = *(const bf16x8*)(kn_g + (long)k0 * 256);
      sv0 = *(const bf16x8*)(vt_g + k0);
    }
  };
  auto vsw = [&](bf16x8 v) -> bf16x8 {
    bf16x8 w = __builtin_shufflevector(v, v, 4, 5, 6, 7, 0, 1, 2, 3);
    return vswap ? w : v;
  };
  auto lstore = [&](int buf) {
    char* kb = lds + buf * BUF; char* vb = kb + KT_BYTES;
    if (MLA) {
      *(bf16x8*)(kb + kn_l) = sk0;
      *(bf16x8*)(kb + kn_l + 32 * KPITCH) = sk1;
      *(bf16x8*)(kb + kp_l) = skp;
      *(bf16x8*)(vb + vt_l) = vsw(sv0);
      *(bf16x8*)(vb + vt_l + 64 * 128) = vsw(sv1);
    } else {
      *(bf16x8*)(kb + kn_l) = sk0;
      *(bf16x8*)(vb + vt_l) = vsw(sv0);
    }
  };
  const int xr = (r32 >> 1) & 7;
  const int krd = r32 * KPITCH;
  const int fv = (xr << 1) | ((r32 >> 4) & 1);
  const int vrd = r32 * 128;
  f32x16 o[NDB];
#pragma unroll
  for (int d = 0; d < NDB; ++d)
#pragma unroll
    for (int r = 0; r < 16; ++r) o[d][r] = 0.f;
  float m_run = -1e30f, l_run = 0.f;

  const bool grpB = false;
  gload(kstart(0)); lstore(0);
  if (grpB && NT > 1) gload(kstart(1));
  __syncthreads();
  for (int j = 0; j < NT; ++j) {
    const char* kb = lds + (j & 1) * BUF; const char* vb = kb + KT_BYTES;
    const bool more = j + 1 < NT;
    if (grpB && more) { lstore((j + 1) & 1); if (j + 2 < NT) gload(kstart(j + 2)); }
    if (!grpB && more) gload(kstart(j + 1));
    f32x16 p0, p1;
#pragma unroll
    for (int r = 0; r < 16; ++r) { p0[r] = 0.f; p1[r] = 0.f; }
#pragma unroll
    for (int s = 0; s < KS; ++s) {
      const int co = ((2 * s + hi) ^ xr) << 4;
      bf16x8 a0 = *(const bf16x8*)(kb + krd + co);
      bf16x8 a1 = *(const bf16x8*)(kb + krd + 32 * KPITCH + co);
      p0 = MFMA(a0, qf[s], p0);
      p1 = MFMA(a1, qf[s], p1);
      if ((s & 3) == 3) __builtin_amdgcn_sched_barrier(0);
    }
    if (!MLA) {
      if (j < nw) {
        const int kp0 = kstart(j) + 4 * hi - qrow;
#pragma unroll
        for (int r = 0; r < 16; ++r) {
          const int d0 = kp0 + (r & 3) + 8 * (r >> 2), d1 = d0 + 32;
          if (d0 > 128 || d0 < -128) p0[r] = -INFINITY;
          if (d1 > 128 || d1 < -128) p1[r] = -INFINITY;
        }
      }
    }
    float pmax = p0[0];
#pragma unroll
    for (int r = 1; r < 16; ++r) pmax = fmaxf(pmax, p0[r]);
#pragma unroll
    for (int r = 0; r < 16; ++r) pmax = fmaxf(pmax, p1[r]);
    pmax = xhalf_max(pmax);
    const float m_new = fmaxf(m_run, pmax);
    const float alpha = __builtin_amdgcn_exp2f(m_run - m_new);
    m_run = m_new;
    float ps = 0.f;
#pragma unroll
    for (int r = 0; r < 16; ++r) { p0[r] = __builtin_amdgcn_exp2f(p0[r] - m_new); ps += p0[r]; }
#pragma unroll
    for (int r = 0; r < 16; ++r) { p1[r] = __builtin_amdgcn_exp2f(p1[r] - m_new); ps += p1[r]; }
    l_run = l_run * alpha + ps;
    if (__any(alpha < 1.f)) {
#pragma unroll
      for (int d = 0; d < NDB; ++d) o[d] *= alpha;
    }
    bf16x8 pb[4];
#pragma unroll
    for (int s = 0; s < 2; ++s) {
      u32x4 w0 = {pk2(p0[8 * s], p0[8 * s + 1]), pk2(p0[8 * s + 2], p0[8 * s + 3]), pk2(p0[8 * s + 4], p0[8 * s + 5]), pk2(p0[8 * s + 6], p0[8 * s + 7])};
      u32x4 w1 = {pk2(p1[8 * s], p1[8 * s + 1]), pk2(p1[8 * s + 2], p1[8 * s + 3]), pk2(p1[8 * s + 4], p1[8 * s + 5]), pk2(p1[8 * s + 6], p1[8 * s + 7])};
      pb[s] = __builtin_bit_cast(bf16x8, w0);
      pb[2 + s] = __builtin_bit_cast(bf16x8, w1);
    }
#pragma unroll
    for (int d = 0; d < NDB; ++d) {
#pragma unroll
      for (int s = 0; s < 4; ++s) {
        const int c8 = 4 * s + hi;
        s16x4 lo = *(const s16x4*)(vb + vrd + d * 32 * 128 + ((c8 ^ fv) << 3));
        s16x4 hi4 = *(const s16x4*)(vb + vrd + d * 32 * 128 + (((c8 + 2) ^ fv) << 3));
        bf16x8 a = __builtin_shufflevector(lo, hi4, 0, 1, 2, 3, 4, 5, 6, 7);
        o[d] = MFMA(a, pb[s], o[d]);
      }
      __builtin_amdgcn_sched_barrier(0);
    }
    if (!grpB && more) lstore((j + 1) & 1);
    __syncthreads();
  }
  float l_tot = xhalf_sum(l_run);
  float fin = 1.f;
  if (!MLA) {
    const float sk = p.sink[hh] * LOG2E;
    const float mf = fmaxf(m_run, sk);
    const float a = __builtin_amdgcn_exp2f(m_run - mf);
    l_tot = l_tot * a + __builtin_amdgcn_exp2f(sk - mf);
    fin = a;
  }
  const float inv = fin / l_tot;
  const u16* gate = (const u16*)(p.ws + (MLA ? OFF_SGA : OFF_SGB)) + tok * 1024 + hh * DV;
  u16* outp = (u16*)(p.ws + (MLA ? OFF_GA : OFF_GB)) + tok * 1024 + hh * DV;
#pragma unroll
  for (int d = 0; d < NDB; ++d) {
#pragma unroll
    for (int g4 = 0; g4 < 4; ++g4) {
      const int dv = d * 32 + 8 * g4 + 4 * hi;
      const u32x2 gv = *(const u32x2*)(gate + dv);
      const float g0 = __uint_as_float(gv[0] << 16), g1 = __uint_as_float(gv[0] & 0xffff0000u);
      const float g2 = __uint_as_float(gv[1] << 16), g3 = __uint_as_float(gv[1] & 0xffff0000u);
      u32x2 ov = {pk2(o[d][4 * g4] * inv * g0, o[d][4 * g4 + 1] * inv * g1), pk2(o[d][4 * g4 + 2] * inv * g2, o[d][4 * g4 + 3] * inv * g3)};
      *(u32x2*)(outp + dv) = ov;
    }
  }
}
DI void attn_mla8_all(const Params& p, char* lds) {
  constexpr int KT_B = 128 * 256, VS_B = 128 * 64, VT_B = 2 * VS_B, BUF8 = KT_B + VT_B;
  const int t = opaque_tid(), lane = t & 63, wid = t >> 6, r32 = lane & 31, hi = lane >> 5;
  constexpr int NT = KEYS / 128;
  auto item_of = [&](int it, int k) -> int {
    if (gridDim.x != 256) return it;
    const int x = blockIdx.x & 7, slot = blockIdx.x >> 3;
    return (x + 8 * (k >> 1)) * 64 + (k & 1) * 32 + slot;
  };
  const int kr = t >> 3, kc = t & 7;
  const int kn_l = kr * 256 + ((kc ^ (kr & 15)) << 4);
  const int pr = t >> 2, pc = t & 3;
  const int kp_l = pr * 256 + (((8 + pc) ^ (pr & 15)) << 4);
  const int dv = t >> 2, vc = t & 3;
  const int vt_l = dv * 64 + ((vc ^ ((dv >> 2) & 3)) << 4);
  const u8 *kn_g, *kp_g, *vt_g;
  i32x8 qf[3];
  auto setptrs = [&](int item) {
    const int bh = item >> 6, hh = bh & 7, b = bh >> 3;
    const int t4 = opaque_tid(), kr = t4 >> 3, kc = t4 & 7, pr = t4 >> 2, pc = t4 & 3, dv = t4 >> 2, vc = t4 & 3;
    kn_g = (const u8*)(p.ws + OFF_KN) + ((long)b * KEYS + kr) * 1024 + hh * 128 + kc * 16;
    kp_g = (const u8*)(p.ws + OFF_KPE) + ((long)b * KEYS + pr) * 64 + pc * 16;
    vt_g = (const u8*)(p.ws + OFF_VT) + ((long)(b * 8 + hh) * 128 + dv) * KEYS + vc * 16;
  };
  auto loadq = [&](int item) {
    const int qb = item & 63, bh = item >> 6, hh = bh & 7, b = bh >> 3;
    const int t5 = opaque_tid(), lane5 = t5 & 63, wid = t5 >> 6, r32 = lane5 & 31, hi = lane5 >> 5;
    const long tk = (long)b * SEQ + qb * 256 + wid * 32 + r32;
    const u8* qp = (const u8*)(p.ws + OFF_Q) + tk * 1536 + hh * 192 + hi * 32;
#pragma unroll
    for (int s = 0; s < 3; ++s) {
      const u32x4 lo = *(const u32x4*)(qp + s * 64), hi4 = *(const u32x4*)(qp + s * 64 + 16);
      qf[s] = i32x8{(int)lo[0], (int)lo[1], (int)lo[2], (int)lo[3], (int)hi4[0], (int)hi4[1], (int)hi4[2], (int)hi4[3]};
    }
  };
  u32x4 sk0, sk1, sp, sv0, sv1;
  auto gload = [&](int k0) {
    sk0 = *(const u32x4*)(kn_g + (long)k0 * 1024);
    sk1 = *(const u32x4*)(kn_g + (long)(k0 + 64) * 1024);
    sp = *(const u32x4*)(kp_g + (long)k0 * 64);
    sv0 = *(const u32x4*)(vt_g + k0);
    sv1 = *(const u32x4*)(vt_g + k0 + 64);
  };
  auto lstore = [&](int buf) {
    char* kb = lds + buf * BUF8; char* vb = kb + KT_B;
    *(u32x4*)(kb + kn_l) = sk0;
    *(u32x4*)(kb + kn_l + 64 * 256) = sk1;
    *(u32x4*)(kb + kp_l) = sp;
    *(u32x4*)(vb + vt_l) = sv0;
    *(u32x4*)(vb + VS_B + vt_l) = sv1;
  };
  const int x15 = r32 & 15, g3 = (r32 >> 2) & 3;
  const int krd = r32 * 256, vrd = r32 * 64;
  constexpr float PSH = 4.f, THR = 4.f;
  int it = blockIdx.x, kq = 0;
  if (it >= P4_MLA_N) return;
  int item = item_of(it, 0);
  setptrs(item); loadq(item); gload(0);
  for (; it < P4_MLA_N; it += gridDim.x, ++kq) {
  const bool has_next = it + (int)gridDim.x < P4_MLA_N;
  const int item_next = has_next ? item_of(it + gridDim.x, kq + 1) : 0;
  f32x16 o[4];
#pragma unroll
  for (int d = 0; d < 4; ++d)
#pragma unroll
    for (int r = 0; r < 16; ++r) o[d][r] = 0.f;
  float m_run = 0.f, l_run = 0.f;
  lstore(0); __syncthreads();
  for (int j = 0; j < NT; ++j) {
    const char* kb = lds + (j & 1) * BUF8; const char* vb = kb + KT_B;
    const bool more = j + 1 < NT;
    if (more) gload((j + 1) * 128);
    else if (has_next) { setptrs(item_next); gload(0); }
    f32x16 pa[4];
#pragma unroll
    for (int kh = 0; kh < 4; ++kh)
#pragma unroll
      for (int r = 0; r < 16; ++r) pa[kh][r] = 0.f;
#pragma unroll
    for (int s = 0; s < 3; ++s) {
      const int c0 = ((4 * s + 2 * hi) ^ x15) << 4, c1 = ((4 * s + 2 * hi + 1) ^ x15) << 4;
#pragma unroll
      for (int kh = 0; kh < 4; ++kh) {
        const u32x4 a0 = *(const u32x4*)(kb + krd + kh * 32 * 256 + c0), a1 = *(const u32x4*)(kb + krd + kh * 32 * 256 + c1);
        const i32x8 a = {(int)a0[0], (int)a0[1], (int)a0[2], (int)a0[3], (int)a1[0], (int)a1[1], (int)a1[2], (int)a1[3]};
        pa[kh] = MFMA8(a, qf[s], pa[kh]);
      }
    }
    float pmax = pa[0][0];
#pragma unroll
    for (int kh = 0; kh < 4; ++kh)
#pragma unroll
      for (int r = 0; r < 16; ++r) pmax = fmaxf(pmax, pa[kh][r]);
    pmax = xhalf_max(pmax);
    const bool first = j == 0;
    const bool need = first || pmax - m_run > THR;
    const float m_new = need ? ceilf(pmax) : m_run;
    if (!first && __any(need)) {
      const float alpha = __builtin_amdgcn_exp2f(m_run - m_new);
      l_run *= alpha;
#pragma unroll
      for (int d = 0; d < 4; ++d) o[d] *= alpha;
    }
    m_run = m_new;
    const float psc = __builtin_amdgcn_exp2f(m_run - PSH);
    i32x8 pb0, pb1;
#pragma unroll
    for (int q = 0; q < 4; ++q) {
      pb0[q] = (int)pk4f8s(__builtin_amdgcn_exp2f(pa[0][4 * q]), __builtin_amdgcn_exp2f(pa[0][4 * q + 1]), __builtin_amdgcn_exp2f(pa[0][4 * q + 2]), __builtin_amdgcn_exp2f(pa[0][4 * q + 3]), psc);
      pb0[4 + q] = (int)pk4f8s(__builtin_amdgcn_exp2f(pa[1][4 * q]), __builtin_amdgcn_exp2f(pa[1][4 * q + 1]), __builtin_amdgcn_exp2f(pa[1][4 * q + 2]), __builtin_amdgcn_exp2f(pa[1][4 * q + 3]), psc);
      pb1[q] = (int)pk4f8s(__builtin_amdgcn_exp2f(pa[2][4 * q]), __builtin_amdgcn_exp2f(pa[2][4 * q + 1]), __builtin_amdgcn_exp2f(pa[2][4 * q + 2]), __builtin_amdgcn_exp2f(pa[2][4 * q + 3]), psc);
      pb1[4 + q] = (int)pk4f8s(__builtin_amdgcn_exp2f(pa[3][4 * q]), __builtin_amdgcn_exp2f(pa[3][4 * q + 1]), __builtin_amdgcn_exp2f(pa[3][4 * q + 2]), __builtin_amdgcn_exp2f(pa[3][4 * q + 3]), psc);
    }
    const int one4 = 0x38383838;
    const i32x8 ones = {one4, one4, one4, one4, one4, one4, one4, one4};
    f32x16 ls;
#pragma unroll
    for (int r = 0; r < 16; ++r) ls[r] = 0.f;
    ls = MFMA8(ones, pb0, ls);
    ls = MFMA8(ones, pb1, ls);
#pragma unroll
    for (int d = 0; d < 4; ++d) {
      const u32x4 v0 = *(const u32x4*)(vb + vrd + d * 32 * 64 + (((2 * hi) ^ g3) << 4));
      const u32x4 v1 = *(const u32x4*)(vb + vrd + d * 32 * 64 + (((2 * hi + 1) ^ g3) << 4));
      const u32x4 w0 = *(const u32x4*)(vb + VS_B + vrd + d * 32 * 64 + (((2 * hi) ^ g3) << 4));
      const u32x4 w1 = *(const u32x4*)(vb + VS_B + vrd + d * 32 * 64 + (((2 * hi + 1) ^ g3) << 4));
      const i32x8 a = {(int)v0[0], (int)v0[1], (int)v0[2], (int)v0[3], (int)v1[0], (int)v1[1], (int)v1[2], (int)v1[3]};
      const i32x8 c = {(int)w0[0], (int)w0[1], (int)w0[2], (int)w0[3], (int)w1[0], (int)w1[1], (int)w1[2], (int)w1[3]};
      o[d] = MFMA8(a, pb0, o[d]);
      o[d] = MFMA8(c, pb1, o[d]);
    }
    l_run += ls[0];
    if (more) lstore((j + 1) & 1);
    __syncthreads();
  }
  if (has_next) loadq(item_next);
  const int te = opaque_tid(), lane_e = te & 63, wid_e = te >> 6, r32e = lane_e & 31, hie = lane_e >> 5;
  const int qbc = item & 63, bhc = item >> 6, hh = bhc & 7, bc = bhc >> 3;
  const long tok = (long)bc * SEQ + qbc * 256 + wid_e * 32 + r32e;
  const float inv = 1.f / l_run;
  const u16* gate = (const u16*)(p.ws + OFF_SGA) + tok * 1024 + hh * 128;
  u16* outp = (u16*)(p.ws + OFF_GA) + tok * 1024 + hh * 128;
#pragma unroll
  for (int d = 0; d < 4; ++d) {
#pragma unroll
    for (int g4 = 0; g4 < 4; ++g4) {
      const int dvo = d * 32 + 8 * g4 + 4 * hie;
      const u32x2 gv = *(const u32x2*)(gate + dvo);
      const float g0 = __uint_as_float(gv[0] << 16), g1 = __uint_as_float(gv[0] & 0xffff0000u);
      const float g2 = __uint_as_float(gv[1] << 16), g3f = __uint_as_float(gv[1] & 0xffff0000u);
      u32x2 ov = {pk2(o[d][4 * g4] * inv * g0, o[d][4 * g4 + 1] * inv * g1), pk2(o[d][4 * g4 + 2] * inv * g2, o[d][4 * g4 + 3] * inv * g3f)};
      *(u32x2*)(outp + dvo) = ov;
    }
  }
  item = item_next;
  }
}
DI void attn_swa_all(const Params& p, char* lds) {
  constexpr int TB = 16384, KPITCH = 128;
  const int t = opaque_tid(), lane = t & 63, wid = t >> 6, r32 = lane & 31, hi = lane >> 5;
  const int srow = t >> 3, sch = t & 7;
  const int st_l = srow * 128 + ((sch ^ ((srow >> 1) & 7)) << 4);
  const bool vswap = srow & 16;
  const int xr = (r32 >> 1) & 7;
  const int krd = r32 * KPITCH;
  const int fv = (xr << 1) | ((r32 >> 4) & 1);
  const int vrd = r32 * 128;
  bf16x8 sk[9], sv[9];
  auto geom = [&](int item, int& b, int& kvh, int& q0, int& wlo, int& nw) {
    const int qb = item & 255, bk = item >> 8; kvh = bk & 3; b = bk >> 2; q0 = qb * 64;
    wlo = q0 - 128 < 0 ? 0 : q0 - 128; const int whi = q0 + 192 > SEQ ? SEQ : q0 + 192; nw = (whi - wlo) >> 6;
  };
  auto gload_item = [&](int item) {
    int b, kvh, q0, wlo, nw; geom(item, b, kvh, q0, wlo, nw);
    const u16* kg = (const u16*)(p.ws + OFF_KS) + ((long)b * KEYS + srow) * 256 + kvh * 64 + sch * 8;
    const u16* vg = (const u16*)(p.ws + OFF_VST) + ((long)(b * 4 + kvh) * 64 + srow) * KEYS + sch * 8;
#pragma unroll
    for (int j = 0; j < 9; ++j) {
      if (j < nw + 4) {
        const int k0 = j < nw ? wlo + j * 64 : SEQ + (j - nw) * 64;
        sk[j] = *(const bf16x8*)(kg + (long)k0 * 256);
        sv[j] = *(const bf16x8*)(vg + k0);
      }
    }
  };
  int item = blockIdx.x;
  if (item < P4_SWA_N) gload_item(item);
  for (; item < P4_SWA_N; item += gridDim.x) {
    int b, kvh, q0, wlo, nw; geom(item, b, kvh, q0, wlo, nw);
    const int NT = nw + 4;
    __syncthreads();
#pragma unroll
    for (int j = 0; j < 9; ++j) {
      if (j < NT) {
        *(bf16x8*)(lds + j * TB + st_l) = sk[j];
        const bf16x8 w = __builtin_shufflevector(sv[j], sv[j], 4, 5, 6, 7, 0, 1, 2, 3);
        *(bf16x8*)(lds + j * TB + 8192 + st_l) = vswap ? w : sv[j];
      }
    }
    __syncthreads();
    if (item + (int)gridDim.x < P4_SWA_N) gload_item(item + gridDim.x);
    const int hh = kvh * 4 + (wid >> 1);
    const int qrow = q0 + (wid & 1) * 32 + r32;
    const long tok = (long)b * SEQ + qrow;
    bf16x8 qf[4];
    {
      const u16* qp = (const u16*)(p.ws + OFF_QS) + tok * 1024 + hh * 64 + hi * 8;
#pragma unroll
      for (int s = 0; s < 4; ++s) qf[s] = *(const bf16x8*)(qp + s * 16);
    }
    f32x16 o[2];
#pragma unroll
    for (int d = 0; d < 2; ++d)
#pragma unroll
      for (int r = 0; r < 16; ++r) o[d][r] = 0.f;
    float m_run = -1e30f, l_run = 0.f;
    for (int j = 0; j < NT; ++j) {
      const char* kb = lds + j * TB; const char* vb = kb + 8192;
      f32x16 p0, p1;
#pragma unroll
      for (int r = 0; r < 16; ++r) { p0[r] = 0.f; p1[r] = 0.f; }
#pragma unroll
      for (int s = 0; s < 4; ++s) {
        const int co = ((2 * s + hi) ^ xr) << 4;
        bf16x8 a0 = *(const bf16x8*)(kb + krd + co);
        bf16x8 a1 = *(const bf16x8*)(kb + krd + 32 * KPITCH + co);
        p0 = MFMA(a0, qf[s], p0);
        p1 = MFMA(a1, qf[s], p1);
      }
      if (j < nw) {
        const int kp0 = wlo + j * 64 + 4 * hi - qrow;
#pragma unroll
        for (int r = 0; r < 16; ++r) {
          const int d0 = kp0 + (r & 3) + 8 * (r >> 2), d1 = d0 + 32;
          if (d0 > 128 || d0 < -128) p0[r] = -INFINITY;
          if (d1 > 128 || d1 < -128) p1[r] = -INFINITY;
        }
      }
      float pmax = p0[0];
#pragma unroll
      for (int r = 1; r < 16; ++r) pmax = fmaxf(pmax, p0[r]);
#pragma unroll
      for (int r = 0; r < 16; ++r) pmax = fmaxf(pmax, p1[r]);
      pmax = xhalf_max(pmax);
      const float m_new = fmaxf(m_run, pmax);
      const float alpha = __builtin_amdgcn_exp2f(m_run - m_new);
      m_run = m_new;
      float ps = 0.f;
#pragma unroll
      for (int r = 0; r < 16; ++r) { p0[r] = __builtin_amdgcn_exp2f(p0[r] - m_new); ps += p0[r]; }
#pragma unroll
      for (int r = 0; r < 16; ++r) { p1[r] = __builtin_amdgcn_exp2f(p1[r] - m_new); ps += p1[r]; }
      l_run = l_run * alpha + ps;
      if (__any(alpha < 1.f)) {
#pragma unroll
        for (int d = 0; d < 2; ++d) o[d] *= alpha;
      }
      bf16x8 pb[4];
#pragma unroll
      for (int s = 0; s < 2; ++s) {
        u32x4 w0 = {pk2(p0[8 * s], p0[8 * s + 1]), pk2(p0[8 * s + 2], p0[8 * s + 3]), pk2(p0[8 * s + 4], p0[8 * s + 5]), pk2(p0[8 * s + 6], p0[8 * s + 7])};
        u32x4 w1 = {pk2(p1[8 * s], p1[8 * s + 1]), pk2(p1[8 * s + 2], p1[8 * s + 3]), pk2(p1[8 * s + 4], p1[8 * s + 5]), pk2(p1[8 * s + 6], p1[8 * s + 7])};
        pb[s] = __builtin_bit_cast(bf16x8, w0);
        pb[2 + s] = __builtin_bit_cast(bf16x8, w1);
      }
#pragma unroll
      for (int d = 0; d < 2; ++d) {
#pragma unroll
        for (int s = 0; s < 4; ++s) {
          const int c8 = 4 * s + hi;
          s16x4 lo = *(const s16x4*)(vb + vrd + d * 32 * 128 + ((c8 ^ fv) << 3));
          s16x4 hi4 = *(const s16x4*)(vb + vrd + d * 32 * 128 + (((c8 + 2) ^ fv) << 3));
          bf16x8 a = __builtin_shufflevector(lo, hi4, 0, 1, 2, 3, 4, 5, 6, 7);
          o[d] = MFMA(a, pb[s], o[d]);
        }
      }
    }
    const int t3 = opaque_tid(), lane3 = t3 & 63, wid3 = t3 >> 6, r32c = lane3 & 31, hic = lane3 >> 5;
    const int hh3 = kvh * 4 + (wid3 >> 1);
    const long tok3 = (long)b * SEQ + q0 + (wid3 & 1) * 32 + r32c;
    float l_tot = xhalf_sum(l_run);
    const float skl = p.sink[hh3] * LOG2E;
    const float mf = fmaxf(m_run, skl);
    const float af = __builtin_amdgcn_exp2f(m_run - mf);
    l_tot = l_tot * af + __builtin_amdgcn_exp2f(skl - mf);
    const float inv = af / l_tot;
    const u16* gate = (const u16*)(p.ws + OFF_SGB) + tok3 * 1024 + hh3 * 64;
    u16* outp = (u16*)(p.ws + OFF_GB) + tok3 * 1024 + hh3 * 64;
#pragma unroll
    for (int d = 0; d < 2; ++d) {
#pragma unroll
      for (int g4 = 0; g4 < 4; ++g4) {
        const int dv = d * 32 + 8 * g4 + 4 * hic;
        const u32x2 gv = *(const u32x2*)(gate + dv);
        const float g0 = __uint_as_float(gv[0] << 16), g1 = __uint_as_float(gv[0] & 0xffff0000u);
        const float g2 = __uint_as_float(gv[1] << 16), g3 = __uint_as_float(gv[1] & 0xffff0000u);
        u32x2 ov = {pk2(o[d][4 * g4] * inv * g0, o[d][4 * g4 + 1] * inv * g1), pk2(o[d][4 * g4 + 2] * inv * g2, o[d][4 * g4 + 3] * inv * g3)};
        *(u32x2*)(outp + dv) = ov;
      }
    }
  }
}
constexpr int P4_MLA = NB * 8 * 64, P4_SWA = NB * 4 * 256;
DI void phase4(const Params& p, char* lds) {
  attn_mla8_all(p, lds);
  __syncthreads();
  attn_swa_all(p, lds);
}

DI void phase5(const Params& p, char* lds) {
  for (int t = blockIdx.x; t < 128 * 8; t += gridDim.x) {
    const int tid_ = opaque_tid();
    const int lane = tid_ & 63, wid = tid_ >> 6, r32 = lane & 31, hi = lane >> 5, wm = wid >> 2, wn = wid & 3;
    const int tp = tperm(t); const int g = tp / 128, wv = tp % 128, mt = g * 16 + (wv & 15), nt = wv >> 4;
    f32x16 acc[4][2];
    zero_acc(acc);
    gemm_mainloop<true>(acc, (const u16*)(p.ws + OFF_GA) + (long)mt * 256 * 1024, 1024, (const u16*)(p.ws + OFF_WBA) + (long)nt * 256 * 1024, 1024, 16, lds);
    const u16* sa = (const u16*)(p.ws + OFF_MGA);
    const u16* sb = (const u16*)(p.ws + OFF_MGB);
    const int tid1 = opaque_tid(); const int lane1 = tid1 & 63, wid1 = tid1 >> 6;
#pragma unroll
    for (int mi = 0; mi < 4; ++mi)
#pragma unroll
      for (int ni = 0; ni < 2; ++ni) {
        const long fo = ((((long)(mt * 8 + nt) * 8 + wid1) * 4 + mi) * 2 + ni) * 1024 + lane1 * 16;
        const u32x4 a0 = *(const u32x4*)(sa + fo), a1 = *(const u32x4*)(sa + fo + 8);
        const u32x4 b0 = *(const u32x4*)(sb + fo), b1 = *(const u32x4*)(sb + fo + 8);
#pragma unroll
        for (int q = 0; q < 4; ++q) {
          acc[mi][ni][2 * q] *= __uint_as_float(a0[q] << 16) * __builtin_amdgcn_rcpf(__uint_as_float(b0[q] << 16));
          acc[mi][ni][2 * q + 1] *= __uint_as_float(a0[q] & 0xffff0000u) * __builtin_amdgcn_rcpf(__uint_as_float(b0[q] & 0xffff0000u));
          acc[mi][ni][8 + 2 * q] *= __uint_as_float(a1[q] << 16) * __builtin_amdgcn_rcpf(__uint_as_float(b1[q] << 16));
          acc[mi][ni][8 + 2 * q + 1] *= __uint_as_float(a1[q] & 0xffff0000u) * __builtin_amdgcn_rcpf(__uint_as_float(b1[q] & 0xffff0000u));
        }
      }
    gemm_mainloop<true>(acc, (const u16*)(p.ws + OFF_GB) + (long)mt * 256 * 1024, 1024, (const u16*)(p.ws + OFF_WBB) + (long)nt * 256 * 1024, 1024, 16, lds);
    const int tid2 = opaque_tid();
    const int lane2 = tid2 & 63, wid2 = tid2 >> 6, r32b = lane2 & 31, hib = lane2 >> 5, wmb = wid2 >> 2, wnb = wid2 & 3;
#pragma unroll
    for (int mi = 0; mi < 4; ++mi)
#pragma unroll
      for (int ni = 0; ni < 2; ++ni) {
        const long mb = mt * 256 + wmb * 128 + mi * 32 + 4 * hib; const int n = nt * 256 + wnb * 64 + ni * 32 + r32b;
        const long fo = ((((long)(mt * 8 + nt) * 8 + wid2) * 4 + mi) * 2 + ni) * 1024 + lane2 * 16;
        const u32x4 b0 = *(const u32x4*)(sb + fo), b1 = *(const u32x4*)(sb + fo + 8);
#pragma unroll
        for (int q = 0; q < 4; ++q) {
          acc[mi][ni][2 * q] *= __uint_as_float(b0[q] << 16);
          acc[mi][ni][2 * q + 1] *= __uint_as_float(b0[q] & 0xffff0000u);
          acc[mi][ni][8 + 2 * q] *= __uint_as_float(b1[q] << 16);
          acc[mi][ni][8 + 2 * q + 1] *= __uint_as_float(b1[q] & 0xffff0000u);
        }
        store_rows((u16*)(p.ws + OFF_M), 2048, mb, n, acc[mi][ni]);
        asm volatile("" ::: "memory"); __builtin_amdgcn_sched_barrier(0);
      }
  }
}

DI void phase6(const Params& p, char* lds) {
  const float* mod = (const float*)(p.ws + OFF_MOD);
  for (int t = blockIdx.x; t < 128 * 8; t += gridDim.x) {
    const int tid_ = opaque_tid();
    const int lane = tid_ & 63, wid = tid_ >> 6, r32 = lane & 31, hi = lane >> 5, wm = wid >> 2, wn = wid & 3;
    const int tp = tperm(t); const int g = tp / 128, wv = tp % 128, mt = g * 16 + (wv & 15), nt = wv >> 4;
    f32x16 acc[4][2];
    zero_acc(acc);
    gemm_mainloop(acc, (const u16*)(p.ws + OFF_M) + (long)mt * 256 * 2048, 2048, (const u16*)(p.ws + OFF_WO) + (long)nt * 256 * 2048, 2048, 32, lds);
    const int bidx = mt >> 6;
#pragma unroll
    for (int ni = 0; ni < 2; ++ni) {
      const int n = nt * 256 + wn * 64 + ni * 32 + r32;
      const float gt = mod[bidx * 6144 + 4096 + n];
#pragma unroll
      for (int mi = 0; mi < 4; ++mi) {
        const long mb = mt * 256 + wm * 128 + mi * 32 + 4 * hi;
        store_rows((u16*)(p.ws + OFF_DLT), 2048, mb, n, acc[mi][ni] * gt);
      }
    }
  }
}

DI void phase7(const Params& p) {
  const int lane = threadIdx.x & 63, wid = threadIdx.x >> 6;
  const u16* dl = (const u16*)(p.ws + OFF_DLT);
  const int stride = gridDim.x * 8;
  int row = blockIdx.x * 8 + wid;
  f32x4 xv[8], xn[8];
  u32x2 dv[8], dn[8];
  if (row < T_LAT) {
#pragma unroll
    for (int i = 0; i < 8; ++i) {
      const int col = (i * 64 + lane) * 4;
      xv[i] = *(const f32x4*)(p.x + (long)row * DM + col);
      dv[i] = *(const u32x2*)(dl + (long)row * DM + col);
    }
  }
  for (; row < T_LAT; row += stride) {
    const int nrow = row + stride;
    if (nrow < T_LAT) {
#pragma unroll
      for (int i = 0; i < 8; ++i) {
        const int col = (i * 64 + lane) * 4;
        xn[i] = *(const f32x4*)(p.x + (long)nrow * DM + col);
        dn[i] = *(const u32x2*)(dl + (long)nrow * DM + col);
      }
    }
    float* yr = p.out + (long)row * DM;
    f32x4 y[8];
    float ss = 0.f;
#pragma unroll
    for (int i = 0; i < 8; ++i) {
      y[i][0] = xv[i][0] + __uint_as_float(dv[i][0] << 16);
      y[i][1] = xv[i][1] + __uint_as_float(dv[i][0] & 0xffff0000u);
      y[i][2] = xv[i][2] + __uint_as_float(dv[i][1] << 16);
      y[i][3] = xv[i][3] + __uint_as_float(dv[i][1] & 0xffff0000u);
      ss += y[i][0] * y[i][0] + y[i][1] * y[i][1] + y[i][2] * y[i][2] + y[i][3] * y[i][3];
    }
#pragma unroll
    for (int o = 1; o < 64; o <<= 1) ss += __shfl_xor(ss, o);
    const float rstd = rsqrtf(ss * (1.f / DM) + EPSN);
#pragma unroll
    for (int i = 0; i < 8; ++i) {
      const int col = (i * 64 + lane) * 4;
      const f32x4 g = *(const f32x4*)(p.final_g + col);
      *(f32x4*)(yr + col) = y[i] * rstd * g;
    }
#pragma unroll
    for (int i = 0; i < 8; ++i) { xv[i] = xn[i]; dv[i] = dn[i]; }
  }
}

__global__ void __launch_bounds__(512) mega(Params p, int ph_lo, int ph_hi) {
  __shared__ __attribute__((aligned(16))) char lds[LDS_BYTES];
  cg::grid_group grid = cg::this_grid();
#define RUN(ph, call) do { if (ph_lo <= (ph) && (ph) < ph_hi) { call; if ((ph) + 1 < ph_hi) { asm volatile("s_waitcnt vmcnt(0) lgkmcnt(0)" ::: "memory"); grid.sync(); } } } while (0)
  RUN(0, phase0(p, lds));
  RUN(1, phase1(p));
  RUN(2, phase2(p, lds));
  RUN(3, phase3(p, lds));
  RUN(4, phase4(p, lds));
  RUN(5, phase5(p, lds));
  RUN(6, phase6(p, lds));
  RUN(7, phase7(p));
#undef RUN
}

extern "C" void kernel_launch(void* const* d_in, const int* in_sizes, int n_in, void* d_out, int out_size, void* d_ws, size_t ws_size, hipStream_t stream) {
  static int grid_blocks = 0;
  if (!grid_blocks) {
    int dev = 0, cus = 0, per_cu = 0;
    hipGetDevice(&dev);
    hipDeviceGetAttribute(&cus, hipDeviceAttributeMultiprocessorCount, dev);
    hipOccupancyMaxActiveBlocksPerMultiprocessor(&per_cu, mega, 512, 0);
    if (per_cu < 1) per_cu = 1;
    if (per_cu > 1) per_cu = 1;
    grid_blocks = cus * per_cu;
    if (ws_size < WS_END) fprintf(stderr, "kernel_launch: workspace too small: %zu < %zu\n", ws_size, WS_END);
  }
  Params p{};
  p.x = (const float*)d_in[0]; p.c = (const float*)d_in[1]; p.ctx = (const float*)d_in[2]; p.c_ctx = (const float*)d_in[3];
  p.w_ada = (const float*)d_in[4]; p.b_ada = (const float*)d_in[5]; p.norm_g = (const float*)d_in[6]; p.w_in = (const float*)d_in[7];
  p.b_in = (const float*)d_in[8]; p.qn_g = (const float*)d_in[9]; p.kvn_g = (const float*)d_in[10]; p.w_uq = (const float*)d_in[11];
  p.w_ukv = (const float*)d_in[12]; p.sink = (const float*)d_in[13]; p.w_ba = (const float*)d_in[14]; p.w_bb = (const float*)d_in[15];
  p.w_o = (const float*)d_in[16]; p.final_g = (const float*)d_in[17];
  p.out = (float*)d_out; p.ws = (char*)d_ws;
#if MULTI_LAUNCH
  for (int ph = 0; ph < 8; ++ph) hipLaunchKernelGGL(mega, dim3(grid_blocks), dim3(512), 0, stream, p, ph, ph + 1);
#else
  int lo = 0, hi = 8;
  void* args[] = {&p, &lo, &hi};
  hipError_t e = hipLaunchCooperativeKernel((void*)mega, dim3(grid_blocks), dim3(512), args, 0, stream);
  if (e != hipSuccess) fprintf(stderr, "cooperative launch failed: %s (grid %d)\n", hipGetErrorString(e), grid_blocks);
#endif
}
```

```cpp
#include <hip/hip_runtime.h>
#include <hip/hip_cooperative_groups.h>
#include <stdint.h>
#include <cstdio>
namespace cg = cooperative_groups;

#ifndef MULTI_LAUNCH
#define MULTI_LAUNCH 0
#endif

typedef unsigned short u16;
typedef short bf16x8 __attribute__((ext_vector_type(8)));
typedef short s16x4 __attribute__((ext_vector_type(4)));
typedef float f32x16 __attribute__((ext_vector_type(16)));
typedef float f32x4 __attribute__((ext_vector_type(4)));
typedef float f32x2 __attribute__((ext_vector_type(2)));
typedef __bf16 bf16x2n __attribute__((ext_vector_type(2)));
typedef unsigned u32x2 __attribute__((ext_vector_type(2)));
typedef unsigned u32x4 __attribute__((ext_vector_type(4)));
#define DI __device__ __forceinline__
#define MFMA(a, b, c) __builtin_amdgcn_mfma_f32_32x32x16_bf16((a), (b), (c), 0, 0, 0)

constexpr int DM = 2048, NB = 2, SEQ = 16384, CTX = 256;
constexpr int T_LAT = NB * SEQ;
constexpr int T_ALL = T_LAT + NB * CTX;
constexpr int KEYS = SEQ + CTX;
constexpr int NIN = 8960;
constexpr float EPSN = 1e-6f;
constexpr float LOG2E = 1.4426950408889634f;

DI int in_src_col(int n) { return n < 1024 ? n : (n < 8704 ? n + 64 : n - 7680); }

constexpr size_t al256(size_t x) { return (x + 255) / 256 * 256; }
constexpr size_t OFF_MOD = 0;
constexpr size_t OFF_ROPE = al256(OFF_MOD + 3 * 6144 * 4);
constexpr size_t OFF_ROWSS = al256(OFF_ROPE + 256 * 16 * 8);
constexpr size_t OFF_BIAS = al256(OFF_ROWSS + (size_t)T_LAT * 4);
constexpr size_t OFF_WIN = al256(OFF_BIAS + NIN * 4);
constexpr size_t OFF_WUQ = al256(OFF_WIN + (size_t)NIN * 2048 * 2);
constexpr size_t OFF_WUKV = al256(OFF_WUQ + (size_t)1536 * 512 * 2);
constexpr size_t OFF_WBA = al256(OFF_WUKV + (size_t)2048 * 512 * 2);
constexpr size_t OFF_WBB = al256(OFF_WBA + (size_t)2048 * 1024 * 2);
constexpr size_t OFF_WO = al256(OFF_WBB + (size_t)2048 * 1024 * 2);
constexpr size_t OFF_H = al256(OFF_WO + (size_t)2048 * 2048 * 2);
constexpr size_t OFF_M = OFF_H;
constexpr size_t OFF_CQ = al256(OFF_H + (size_t)T_ALL * 2048 * 2);
constexpr size_t OFF_CKV = OFF_CQ + (size_t)T_LAT * 512 * 2;
constexpr size_t OFF_GA = OFF_CQ;
constexpr size_t OFF_KPE = al256(OFF_CKV + (size_t)T_ALL * 512 * 2);
constexpr size_t OFF_SGA = al256(OFF_KPE + (size_t)NB * KEYS * 64 * 2);
constexpr size_t OFF_SGB = al256(OFF_SGA + (size_t)T_LAT * 1024 * 2);
constexpr size_t OFF_QS = al256(OFF_SGB + (size_t)T_LAT * 1024 * 2);
constexpr size_t OFF_KS = al256(OFF_QS + (size_t)T_LAT * 1024 * 2);
constexpr size_t OFF_VST = al256(OFF_KS + (size_t)NB * KEYS * 256 * 2);
constexpr size_t OFF_MGA = al256(OFF_VST + (size_t)NB * 4 * 64 * KEYS * 2);
constexpr size_t OFF_MGB = al256(OFF_MGA + (size_t)T_LAT * 2048 * 2);
constexpr size_t OFF_DLT = OFF_MGA;
constexpr size_t OFF_Q = al256(OFF_MGB + (size_t)T_LAT * 2048 * 2);
constexpr size_t OFF_KN = al256(OFF_Q + (size_t)T_LAT * 1536 * 2);
constexpr size_t OFF_VT = al256(OFF_KN + (size_t)NB * KEYS * 1024 * 2);
constexpr size_t OFF_GB = al256(OFF_VT + (size_t)NB * 8 * 128 * KEYS * 2);
constexpr size_t WS_END = al256(OFF_GB + (size_t)T_LAT * 1024 * 2);
static_assert(WS_END <= (size_t)4 * T_LAT * DM * 4, "workspace too big");
static_assert((size_t)T_LAT * 1024 * 2 <= (size_t)T_LAT * 512 * 2 + (size_t)T_ALL * 512 * 2, "ga alias");

struct Params {
  const float *x, *c, *ctx, *c_ctx, *w_ada, *b_ada, *norm_g, *w_in, *b_in, *qn_g, *kvn_g, *w_uq, *w_ukv, *sink, *w_ba, *w_bb, *w_o, *final_g;
  float* out;
  char* ws;
};

DI unsigned pk2(float a, float b) { f32x2 v = {a, b}; bf16x2n r = __builtin_convertvector(v, bf16x2n); return __builtin_bit_cast(unsigned, r); }
DI u16 f2bf(float a) { return (u16)(pk2(a, 0.f) & 0xffffu); }
typedef int i32x8 __attribute__((ext_vector_type(8)));
typedef unsigned char u8;
DI unsigned pk4f8(float a, float b, float c, float d) { int w = 0; w = __builtin_amdgcn_cvt_pk_fp8_f32(a, b, w, false); w = __builtin_amdgcn_cvt_pk_fp8_f32(c, d, w, true); return (unsigned)w; }
typedef short s16x2 __attribute__((ext_vector_type(2)));
DI unsigned pk4f8s(float a, float b, float c, float d, float sc) {
  s16x2 w = {0, 0};
  w = __builtin_amdgcn_cvt_scalef32_pk_fp8_f32(w, a, b, sc, false);
  w = __builtin_amdgcn_cvt_scalef32_pk_fp8_f32(w, c, d, sc, true);
  return __builtin_bit_cast(unsigned, w);
}
DI u8 f2f8(float a) { return (u8)(__builtin_amdgcn_cvt_pk_fp8_f32(a, a, 0, false) & 0xff); }
#define MFMA8(a, b, c) __builtin_amdgcn_mfma_scale_f32_32x32x64_f8f6f4((a), (b), (c), 0, 0, 0, 0, 0, 0)
DI float bf2f(u16 v) { return __uint_as_float(((unsigned)v) << 16); }
DI int opaque_tid() { int t = threadIdx.x; asm volatile("" : "+v"(t)); return t; }
DI int tperm(int t) {
  if (gridDim.x != 256) return t;
  const int b = t & 255, x = b & 7, slot = b >> 3;
  return (t & ~255) | ((8 * (x >> 2) + (slot >> 2)) * 16 + 4 * (x & 3) + (slot & 3));
}
DI int crow(int r, int hi) { return (r & 3) + 8 * (r >> 2) + 4 * hi; }
DI float siluf(float x) { return x * __builtin_amdgcn_rcpf(1.f + __expf(-x)); }
DI float sigmf(float x) { return __builtin_amdgcn_rcpf(1.f + __expf(-x)); }
DI void bkey(int m, int& b, int& key) {
  if (m < T_LAT) { b = m >> 14; key = m & (SEQ - 1); }
  else { int u = m - T_LAT; b = u >> 8; key = SEQ + (u & 255); }
}
DI float xhalf_max(float v) {
  auto rr = __builtin_amdgcn_permlane32_swap(__float_as_uint(v), __float_as_uint(v), false, false);
  return fmaxf(__uint_as_float(rr[0]), __uint_as_float(rr[1]));
}
DI float xhalf_sum(float v) {
  auto rr = __builtin_amdgcn_permlane32_swap(__float_as_uint(v), __float_as_uint(v), false, false);
  return __uint_as_float(rr[0]) + __uint_as_float(rr[1]);
}

constexpr int P4_SWA_N = NB * 4 * 256;
constexpr int P4_MLA_N = NB * 8 * 64;
constexpr int BM = 256, BN = 256, BK = 64;
constexpr int LDS_A = BM * BK * 2, LDS_B = BN * BK * 2, LDS_STAGE = LDS_A + LDS_B;
constexpr int LDS_GEMM = 2 * LDS_STAGE;
constexpr int LDS_BYTES = 9 * 16384;

template <bool PP = true, bool PIN = true>
DI void gemm_mainloop(f32x16 (&acc)[4][2], const u16* __restrict__ A, long lda, const u16* __restrict__ Bt, long ldb, int nk, char* lds) {
  const int t = opaque_tid(), lane = t & 63, wid = t >> 6, r32 = lane & 31, hi = lane >> 5;
  const int wm = wid >> 2, wn = wid & 3;
  const int lrow = t >> 3, lch = t & 7;
  const u16* ag = A + (long)lrow * lda + lch * 8;
  const u16* bg = Bt + (long)lrow * ldb + lch * 8;
  const int wofs = lrow * 128 + ((lch ^ ((lrow >> 1) & 7)) << 4);
  bf16x8 ra[4], rb[4];
#define GLOAD(KT) do { const u16* ag2 = ag + (KT) * BK; const u16* bg2 = bg + (KT) * BK;                             \
    _Pragma("unroll") for (int pp = 0; pp < 4; ++pp) ra[pp] = *(const bf16x8*)(ag2 + (long)(64 * pp) * lda);      \
    _Pragma("unroll") for (int pp = 0; pp < 4; ++pp) rb[pp] = *(const bf16x8*)(bg2 + (long)(64 * pp) * ldb); } while (0)
#define LSTORE(ST) do { char* da = lds + (ST) * LDS_STAGE;                                                           \
    _Pragma("unroll") for (int pp = 0; pp < 4; ++pp) *(bf16x8*)(da + wofs + pp * 8192) = ra[pp];                   \
    _Pragma("unroll") for (int pp = 0; pp < 4; ++pp) *(bf16x8*)(da + LDS_A + wofs + pp * 8192) = rb[pp]; } while (0)
  const int xr = (r32 >> 1) & 7;
  const int arow0 = (wm * 128 + r32) * 128, brow0 = (wn * 64 + r32) * 128;
  GLOAD(0);
  LSTORE(0);
  if (PP && nk > 1) GLOAD(1);
  __syncthreads();
  for (int kt = 0; kt < nk; ++kt) {
    const char* sa = lds + (kt & 1) * LDS_STAGE;
    const char* sb = sa + LDS_A;
    char* da = lds + ((kt + 1) & 1) * LDS_STAGE;
    const bool more = kt + 1 < nk, more2 = kt + 2 < nk;
    if (!PP && more) GLOAD(kt + 1);
    bf16x8 fa[4], fb[2], na[4], nb[2];
    {
      const int co = ((hi ^ xr) << 4);
      fb[0] = *(const bf16x8*)(sb + brow0 + co); fb[1] = *(const bf16x8*)(sb + brow0 + 32 * 128 + co);
#pragma unroll
      for (int mi = 0; mi < 4; ++mi) fa[mi] = *(const bf16x8*)(sa + arow0 + mi * 32 * 128 + co);
    }
#pragma unroll
    for (int s = 0; s < 4; ++s) {
      if (s < 3) {
        const int co = (((2 * (s + 1) + hi) ^ xr) << 4);
        nb[0] = *(const bf16x8*)(sb + brow0 + co); nb[1] = *(const bf16x8*)(sb + brow0 + 32 * 128 + co);
#pragma unroll
        for (int mi = 0; mi < 4; ++mi) na[mi] = *(const bf16x8*)(sa + arow0 + mi * 32 * 128 + co);
      }
      if (PIN) __builtin_amdgcn_sched_barrier(0);
#pragma unroll
      for (int mi = 0; mi < 4; ++mi) {
        acc[mi][0] = MFMA(fa[mi], fb[0], acc[mi][0]);
        acc[mi][1] = MFMA(fa[mi], fb[1], acc[mi][1]);
      }
      if (PP && more) {
        *(bf16x8*)(da + wofs + s * 8192) = ra[s];
        *(bf16x8*)(da + LDS_A + wofs + s * 8192) = rb[s];
        if (more2) {
          ra[s] = *(const bf16x8*)(ag + (kt + 2) * BK + (long)(64 * s) * lda);
          rb[s] = *(const bf16x8*)(bg + (kt + 2) * BK + (long)(64 * s) * ldb);
        }
      }
      if (PIN) __builtin_amdgcn_sched_barrier(0);
      if (s < 3) {
#pragma unroll
        for (int mi = 0; mi < 4; ++mi) fa[mi] = na[mi];
        fb[0] = nb[0]; fb[1] = nb[1];
      }
    }
    if (!PP && more) LSTORE((kt + 1) & 1);
    __syncthreads();
  }
#undef GLOAD
#undef LSTORE
}
DI void zero_acc(f32x16 (&acc)[4][2]) {
#pragma unroll
  for (int i = 0; i < 4; ++i)
#pragma unroll
    for (int j = 0; j < 2; ++j)
#pragma unroll
      for (int r = 0; r < 16; ++r) acc[i][j][r] = 0.f;
}

DI void p0_adaln(const Params& p, int item, char* lds) {
  float* sil = (float*)lds;
  float* red = (float*)(lds + 24576);
  const int t = opaque_tid();
  for (int i = t; i < 3 * 2048; i += 512) {
    int v = i >> 11, k = i & 2047;
    float cv = v < 2 ? p.c[v * 2048 + k] : p.c_ctx[k];
    sil[i] = siluf(cv);
  }
  __syncthreads();
  const int n0 = item * 64, cgp = t & 15, kl = t >> 4;
  f32x4 a0 = {0, 0, 0, 0}, a1 = a0, a2 = a0;
  const float* wp = p.w_ada + n0 + cgp * 4;
#pragma unroll 8
  for (int k = kl; k < 2048; k += 32) {
    f32x4 w = *(const f32x4*)(wp + (long)k * 6144);
    a0 += w * sil[k]; a1 += w * sil[2048 + k]; a2 += w * sil[4096 + k];
  }
#pragma unroll
  for (int i = 0; i < 4; ++i) {
    red[(kl * 3 + 0) * 64 + cgp * 4 + i] = a0[i];
    red[(kl * 3 + 1) * 64 + cgp * 4 + i] = a1[i];
    red[(kl * 3 + 2) * 64 + cgp * 4 + i] = a2[i];
  }
  __syncthreads();
  if (t < 192) {
    int v = t >> 6, col = t & 63;
    float s = 0.f;
    for (int k = 0; k < 32; ++k) s += red[(k * 3 + v) * 64 + col];
    float* mod = (float*)(p.ws + OFF_MOD);
    mod[v * 6144 + n0 + col] = s + p.b_ada[n0 + col];
  }
  __syncthreads();
}
DI void p0_rope(const Params& p) {
  f32x2* tab = (f32x2*)(p.ws + OFF_ROPE);
  const int t = threadIdx.x;
  for (int e = 0; e < 8; ++e) {
    int idx = t * 8 + e, pos = idx >> 4, j = idx & 15;
    float inv = exp2f(-(float)j * (13.287712379549449f / 16.f));
    float ang = (float)pos * inv;
    float kk = rintf(ang * 0.15915494309189535f);
    double rd = (double)ang - (double)kk * 6.283185307179586;
    float r = (float)rd;
    f32x2 cs = {cosf(r), sinf(r)};
    tab[idx] = cs;
  }
}
DI void p0_zero(const Params& p) {
  float* rs = (float*)(p.ws + OFF_ROWSS);
  for (int i = threadIdx.x; i < T_LAT; i += 512) rs[i] = 0.f;
}
DI void p0_transpose(const float* __restrict__ src, long lds_src, int k0, u16* __restrict__ dst, long ldd, int n0,
                     const float* __restrict__ g, bool is_win, char* lds) {
  float (*tile)[257] = (float (*)[257])lds;
  const int t = opaque_tid();
  f32x4 v[8];
#pragma unroll
  for (int pp = 0; pp < 8; ++pp) {
    const int idx = t + 512 * pp, kr = idx >> 6, col = (idx & 63) * 4;
    const int nb = n0 + (col & ~63);
    const bool zero = is_win && nb >= 8768;
    const int sc = (is_win ? in_src_col(nb) : nb) + (col & 63);
    v[pp] = f32x4{0, 0, 0, 0};
    if (!zero) v[pp] = *(const f32x4*)(src + (long)(k0 + kr) * lds_src + sc);
  }
#pragma unroll
  for (int pp = 0; pp < 8; ++pp) {
    const int idx = t + 512 * pp, kr = idx >> 6, col = (idx & 63) * 4;
    f32x4 w = v[pp];
    if (g) w *= g[k0 + kr];
    tile[kr][col + 0] = w[0]; tile[kr][col + 1] = w[1]; tile[kr][col + 2] = w[2]; tile[kr][col + 3] = w[3];
  }
  __syncthreads();
#pragma unroll
  for (int q = 0; q < 4; ++q) {
    const int o = t + 512 * q, n = o >> 3, kc = o & 7;
    u32x4 ov;
    ov[0] = pk2(tile[kc * 8 + 0][n], tile[kc * 8 + 1][n]);
    ov[1] = pk2(tile[kc * 8 + 2][n], tile[kc * 8 + 3][n]);
    ov[2] = pk2(tile[kc * 8 + 4][n], tile[kc * 8 + 5][n]);
    ov[3] = pk2(tile[kc * 8 + 6][n], tile[kc * 8 + 7][n]);
    *(u32x4*)(dst + (long)(n0 + n) * ldd + k0 + kc * 8) = ov;
  }
  __syncthreads();
}
constexpr int P0_ADA = 96, P0_MISC = 1;
constexpr int P0_WIN = 35 * 32, P0_WUQ = 6 * 8, P0_WUKV = 8 * 8, P0_WB = 8 * 16, P0_WO = 8 * 32;
constexpr int P0_TOTAL = P0_ADA + P0_MISC + P0_WIN + P0_WUQ + P0_WUKV + 2 * P0_WB + P0_WO;
DI void phase0(const Params& p, char* lds) {
  for (int it = blockIdx.x; it < P0_TOTAL; it += gridDim.x) {
    int i = it;
    if (i < P0_ADA) { p0_adaln(p, i, lds); continue; }
    i -= P0_ADA;
    if (i == 0) { p0_rope(p); continue; }
    i -= P0_MISC;
    if (i < P0_WIN) {
      const int ntile = i >> 5, ktile = i & 31, n0 = ntile * 256;
      if (ktile == 0 && threadIdx.x < 256) {
        const int n = n0 + threadIdx.x;
        ((float*)(p.ws + OFF_BIAS))[n] = n >= 8768 ? 0.f : p.b_in[in_src_col(n)];
      }
      p0_transpose(p.w_in, 8768, ktile * 64, (u16*)(p.ws + OFF_WIN), 2048, n0, nullptr, true, lds);
      continue;
    }
    i -= P0_WIN;
    if (i < P0_WUQ) { const int ntile = i >> 3, ktile = i & 7; p0_transpose(p.w_uq, 1536, ktile * 64, (u16*)(p.ws + OFF_WUQ), 512, ntile * 256, p.qn_g, false, lds); continue; }
    i -= P0_WUQ;
    if (i < P0_WUKV) { const int ntile = i >> 3, ktile = i & 7; p0_transpose(p.w_ukv, 2048, ktile * 64, (u16*)(p.ws + OFF_WUKV), 512, ntile * 256, p.kvn_g, false, lds); continue; }
    i -= P0_WUKV;
    if (i < P0_WB) { const int ntile = i >> 4, ktile = i & 15; p0_transpose(p.w_ba, 2048, ktile * 64, (u16*)(p.ws + OFF_WBA), 1024, ntile * 256, nullptr, false, lds); continue; }
    i -= P0_WB;
    if (i < P0_WB) { const int ntile = i >> 4, ktile = i & 15; p0_transpose(p.w_bb, 2048, ktile * 64, (u16*)(p.ws + OFF_WBB), 1024, ntile * 256, nullptr, false, lds); continue; }
    i -= P0_WB;
    { const int ntile = i >> 5, ktile = i & 31; p0_transpose(p.w_o, 2048, ktile * 64, (u16*)(p.ws + OFF_WO), 2048, ntile * 256, nullptr, false, lds); }
  }
}

DI void phase1(const Params& p) {
  const int lane = threadIdx.x & 63, wid = threadIdx.x >> 6;
  const float* mod = (const float*)(p.ws + OFF_MOD);
  u16* h = (u16*)(p.ws + OFF_H);
  const int stride = gridDim.x * 8;
  int row = blockIdx.x * 8 + wid;
  f32x4 xv[8], xn[8];
  if (row < T_ALL) {
    const float* xr = row < T_LAT ? p.x + (long)row * DM : p.ctx + (long)(row - T_LAT) * DM;
#pragma unroll
    for (int i = 0; i < 8; ++i) xv[i] = *(const f32x4*)(xr + (i * 64 + lane) * 4);
  }
  for (; row < T_ALL; row += stride) {
    const int nrow = row + stride;
    if (nrow < T_ALL) {
      const float* xr = nrow < T_LAT ? p.x + (long)nrow * DM : p.ctx + (long)(nrow - T_LAT) * DM;
#pragma unroll
      for (int i = 0; i < 8; ++i) xn[i] = *(const f32x4*)(xr + (i * 64 + lane) * 4);
    }
    const int v = row < T_LAT ? (row >> 14) : 2;
    float ss = 0.f;
#pragma unroll
    for (int i = 0; i < 8; ++i) ss += xv[i][0] * xv[i][0] + xv[i][1] * xv[i][1] + xv[i][2] * xv[i][2] + xv[i][3] * xv[i][3];
#pragma unroll
    for (int o = 1; o < 64; o <<= 1) ss += __shfl_xor(ss, o);
    const float rstd = rsqrtf(ss * (1.f / DM) + EPSN);
#pragma unroll
    for (int i = 0; i < 8; ++i) {
      const int col = (i * 64 + lane) * 4;
      f32x4 g = *(const f32x4*)(p.norm_g + col);
      f32x4 sh = *(const f32x4*)(mod + v * 6144 + col);
      f32x4 sc = *(const f32x4*)(mod + v * 6144 + 2048 + col);
      f32x4 y = (xv[i] * rstd) * g * (sc + 1.f) + sh;
      u32x2 o = {pk2(y[0], y[1]), pk2(y[2], y[3])};
      *(u32x2*)(h + (long)row * DM + col) = o;
    }
#pragma unroll
    for (int i = 0; i < 8; ++i) xv[i] = xn[i];
  }
}

DI void store_rows(u16* __restrict__ dst, long ld, long row0, int col, const f32x16& v) {
  const bool odd = col & 1;
  u16* base = dst + (row0 + (odd ? 1 : 0)) * ld + (col & ~1);
#pragma unroll
  for (int q = 0; q < 8; ++q) {
    const float ve = v[2 * q], vo = v[2 * q + 1];
    const float send = odd ? ve : vo;
    const float got = __int_as_float(__builtin_amdgcn_update_dpp(0, __float_as_int(send), 0xB1, 0xF, 0xF, true));
    const unsigned pk = odd ? pk2(got, vo) : pk2(ve, got);
    *(unsigned*)(base + (long)((2 * q & 3) + 8 * (q >> 1)) * ld) = pk;
  }
}
DI void store_rows8(u8* __restrict__ dst, long ld, long row0, int col, const f32x16& v) {
#pragma unroll
  for (int r = 0; r < 16; ++r) dst[(row0 + (r & 3) + 8 * (r >> 2)) * ld + col] = f2f8(v[r]);
}
DI void inproj_epilogue(const Params& p, f32x16 (&acc)[4][2], int mt, int nt256) {
  const int tid_ = opaque_tid();
  const int lane = tid_ & 63, wid = tid_ >> 6, r32 = lane & 31, hi = lane >> 5, wm = wid >> 2, wn = wid & 3;
  const int m0 = mt * 256 + wm * 128, n0 = nt256 * 256 + wn * 64;
  const int nt = n0 >> 7;
  const bool lat = mt < 128;
  const int type = nt < 4 ? 0 : nt < 8 ? 1 : nt < 16 ? 2 : nt < 24 ? 3 : nt < 26 ? 4 : nt < 28 ? 5 : nt < 36 ? 6 : nt < 52 ? 7 : nt < 68 ? 8 : 9;
  if (n0 >= 8768) return;
  if (!lat && !(type == 1 || type == 4 || type == 5 || type == 9)) return;
  const float* bias = (const float*)(p.ws + OFF_BIAS);
  const f32x2* rope = (const f32x2*)(p.ws + OFF_ROPE);
#pragma unroll
  for (int ni = 0; ni < 2; ++ni) {
    const int n = n0 + ni * 32 + r32;
    const float bv = bias[n];
#pragma unroll
    for (int mi = 0; mi < 4; ++mi) {
      f32x16 z = acc[mi][ni] + bv;
      const int mb = m0 + mi * 32 + 4 * hi;
      if (type == 3 || ((type == 4 || type == 9) && lat)) {
#pragma unroll
        for (int r = 0; r < 16; ++r) {
          const int m = mb + (r & 3) + 8 * (r >> 2);
          const int s = m & (SEQ - 1);
          const int pos = ni == 0 ? (s >> 6) : (s & 63);
          const f32x2 cs = rope[pos * 16 + (r32 & 15)];
          const float pr = __shfl_xor(z[r], 16);
          z[r] = (r32 & 16) ? z[r] * cs[0] + pr * cs[1] : z[r] * cs[0] - pr * cs[1];
        }
      }
      if (type == 0) { store_rows((u16*)(p.ws + OFF_CQ), 512, mb, n, z); }
      else if (type == 1) { store_rows((u16*)(p.ws + OFF_CKV), 512, mb, n - 512, z); }
      else if (type == 2 || type == 6) {
#pragma unroll
        for (int r = 0; r < 16; ++r) z[r] = siluf(z[r]);
        store_rows((u16*)(p.ws + (type == 2 ? OFF_SGA : OFF_SGB)), 1024, mb, n - (type == 2 ? 1024 : 3584), z);
      } else if (type == 3) {
        z *= (0.125f * LOG2E);
        store_rows((u16*)(p.ws + OFF_QS), 1024, mb, n - 2048, z);
      } else if (type == 4 || type == 9) {
        int b, key; bkey(mb, b, key);
        const long kr = (long)b * KEYS + key;
        if (type == 4) store_rows((u16*)(p.ws + OFF_KS), 256, kr, n - 3072, z);
        else store_rows8((u8*)(p.ws + OFF_KPE), 64, kr, n - 8704, z);
      } else if (type == 5) {
        const int nn = n - 3328, kvh = nn >> 6, dv = nn & 63;
        int b, key; bkey(mb, b, key);
        u16* vst = (u16*)(p.ws + OFF_VST) + ((long)(b * 4 + kvh) * 64 + dv) * KEYS + key;
#pragma unroll
        for (int g4 = 0; g4 < 4; ++g4) {
          u32x2 o = {pk2(z[4 * g4], z[4 * g4 + 1]), pk2(z[4 * g4 + 2], z[4 * g4 + 3])};
          *(u32x2*)(vst + 8 * g4) = o;
        }
      } else {
#pragma unroll
        for (int r = 0; r < 16; ++r) z[r] = sigmf(z[r]);
        const int ntm = nt256 - (type == 7 ? 18 : 26);
        u16* fp = (u16*)(p.ws + (type == 7 ? OFF_MGA : OFF_MGB)) + ((((long)(mt * 8 + ntm) * 8 + wid) * 4 + mi) * 2 + ni) * 1024 + lane * 16;
        u32x4 o0 = {pk2(z[0], z[1]), pk2(z[2], z[3]), pk2(z[4], z[5]), pk2(z[6], z[7])};
        u32x4 o1 = {pk2(z[8], z[9]), pk2(z[10], z[11]), pk2(z[12], z[13]), pk2(z[14], z[15])};
        *(u32x4*)fp = o0; *(u32x4*)(fp + 8) = o1;
      }
    }
  }
}
constexpr int P2_LAT = 128 * 35, P2_TOTAL = P2_LAT + 10;
DI void phase2(const Params& p, char* lds) {
  const u16* h = (const u16*)(p.ws + OFF_H);
  const u16* w = (const u16*)(p.ws + OFF_WIN);
  for (int t = blockIdx.x; t < P2_TOTAL; t += gridDim.x) {
    int mt, nt;
    if (t < P2_LAT) { const int tp = (t < (P2_LAT & ~255)) ? tperm(t) : t; int g = tp / (16 * 35), wv = tp % (16 * 35); mt = g * 16 + (wv & 15); nt = wv >> 4; }
    else { int u = t - P2_LAT; mt = 128 + (u & 1); int idx = u >> 1; nt = idx < 2 ? 2 + idx : idx < 4 ? 10 + idx : 34; }
    f32x16 acc[4][2]; zero_acc(acc);
    gemm_mainloop(acc, h + (long)mt * 256 * 2048, 2048, w + (long)nt * 256 * 2048, 2048, 32, lds);
    inproj_epilogue(p, acc, mt, nt);
  }
}

DI void row_rstd(const u16* __restrict__ cbase, char* lds) {
  float* rs = (float*)(lds + LDS_GEMM);
  const int tid_ = opaque_tid();
  const int lane = tid_ & 63, wid = tid_ >> 6;
  const int sub = lane >> 4, l16 = lane & 15;
#pragma unroll
  for (int ps = 0; ps < 8; ++ps) {
    const int row = wid * 32 + ps * 4 + sub;
    const u16* rp = cbase + (long)row * 512 + l16 * 8;
    float ss = 0.f;
#pragma unroll
    for (int q = 0; q < 4; ++q) {
      bf16x8 v = *(const bf16x8*)(rp + q * 128);
#pragma unroll
      for (int e = 0; e < 8; ++e) { float f = bf2f((u16)v[e]); ss += f * f; }
    }
    ss += __shfl_xor(ss, 1); ss += __shfl_xor(ss, 2); ss += __shfl_xor(ss, 4); ss += __shfl_xor(ss, 8);
    if (l16 == 0) rs[row] = rsqrtf(ss * (1.f / 512.f) + EPSN);
  }
}
constexpr float QSCALE = 0.07216878364870323f * LOG2E;
constexpr int P3_Q = 128 * 6, P3_KV = 128 * 8, P3_TOTAL = P3_Q + P3_KV + 16;
DI void phase3(const Params& p, char* lds) {
  const float* rs = (const float*)(lds + LDS_GEMM);
  const f32x2* rope = (const f32x2*)(p.ws + OFF_ROPE);
  for (int t = blockIdx.x; t < P3_TOTAL; t += gridDim.x) {
    const int tid_ = opaque_tid();
    const int lane = tid_ & 63, wid = tid_ >> 6, r32 = lane & 31, hi = lane >> 5, wm = wid >> 2, wn = wid & 3;
    f32x16 acc[4][2]; zero_acc(acc);
    if (t < P3_Q) {
      const int tp = tperm(t); const int g = tp / (16 * 6), wv = tp % (16 * 6), mt = g * 16 + (wv & 15), nt = wv >> 4;
      const u16* A = (const u16*)(p.ws + OFF_CQ) + (long)mt * 256 * 512;
      row_rstd(A, lds);
      gemm_mainloop<true, false>(acc, A, 512, (const u16*)(p.ws + OFF_WUQ) + (long)nt * 256 * 512, 512, 8, lds);
      u8* Q = (u8*)(p.ws + OFF_Q);
#pragma unroll
      for (int mi = 0; mi < 4; ++mi) {
        const int lrow = wm * 128 + mi * 32 + 4 * hi;
        const int mb = mt * 256 + lrow;
        float rsv[16];
#pragma unroll
        for (int r = 0; r < 16; ++r) rsv[r] = rs[lrow + (r & 3) + 8 * (r >> 2)];
#pragma unroll
        for (int ni = 0; ni < 2; ++ni) {
          const int n = nt * 256 + wn * 64 + ni * 32 + r32;
          const int c6 = (nt * 8 + wn * 2 + ni) % 6;
          f32x16 z = acc[mi][ni];
#pragma unroll
          for (int r = 0; r < 16; ++r) z[r] *= rsv[r];
          if (c6 >= 4) {
#pragma unroll
            for (int r = 0; r < 16; ++r) {
              const int s = (mb + (r & 3) + 8 * (r >> 2)) & (SEQ - 1);
              const int pos = c6 == 4 ? (s >> 6) : (s & 63);
              const f32x2 cs = rope[pos * 16 + (r32 & 15)];
              const float pr = __shfl_xor(z[r], 16);
              z[r] = (r32 & 16) ? z[r] * cs[0] + pr * cs[1] : z[r] * cs[0] - pr * cs[1];
            }
          }
          z *= QSCALE;
          store_rows8(Q, 1536, mb, n, z);
        }
        asm volatile("" ::: "memory"); __builtin_amdgcn_sched_barrier(0);
      }
    } else {
      int u = t - P3_Q, mt, nt;
      if (u < P3_KV) { const int up = tperm(u); const int g = up / 128, wv = up % 128; mt = g * 16 + (wv & 15); nt = wv >> 4; }
      else { u -= P3_KV; mt = 128 + (u & 1); nt = u >> 1; }
      const u16* A = (const u16*)(p.ws + OFF_CKV) + (long)mt * 256 * 512;
      row_rstd(A, lds);
      gemm_mainloop<true, false>(acc, A, 512, (const u16*)(p.ws + OFF_WUKV) + (long)nt * 256 * 512, 512, 8, lds);
      const int hh = nt;
      const bool isv = wn >> 1;
#pragma unroll
      for (int mi = 0; mi < 4; ++mi) {
        const int lrow = wm * 128 + mi * 32 + 4 * hi;
        const int mb = mt * 256 + lrow;
        float rsv[16];
#pragma unroll
        for (int r = 0; r < 16; ++r) rsv[r] = rs[lrow + (r & 3) + 8 * (r >> 2)];
        int b, key; bkey(mb, b, key);
#pragma unroll
        for (int ni = 0; ni < 2; ++ni) {
          const int c = (wn & 1) * 64 + ni * 32 + r32;
          f32x16 z = acc[mi][ni];
#pragma unroll
          for (int r = 0; r < 16; ++r) z[r] *= rsv[r];
          if (!isv) {
            store_rows8((u8*)(p.ws + OFF_KN), 1024, (long)b * KEYS + key, hh * 128 + c, z);
          } else {
            u8* vt = (u8*)(p.ws + OFF_VT) + ((long)(b * 8 + hh) * 128 + c) * KEYS;
#pragma unroll
            for (int g4 = 0; g4 < 4; ++g4) {
              const int k0 = key + 8 * g4, w = k0 & 63;
              const int pos = (k0 & ~63) + 32 * ((w >> 2) & 1) + 4 * ((w >> 3) & 3) + 16 * (w >> 5);
              *(unsigned*)(vt + pos) = pk4f8(z[4 * g4], z[4 * g4 + 1], z[4 * g4 + 2], z[4 * g4 + 3]);
            }
          }
        }
        asm volatile("" ::: "memory"); __builtin_amdgcn_sched_barrier(0);
      }
    }
    __syncthreads();
  }
}

template <bool MLA>
DI void attn_item(const Params& p, int item, char* lds) {
  constexpr int DQK = MLA ? 192 : 64, KS = DQK / 16, DV = MLA ? 128 : 64, NDB = DV / 32;
  constexpr int KPITCH = DQK * 2, KT_BYTES = 64 * KPITCH, VT_BYTES = DV * 128, BUF = KT_BYTES + VT_BYTES;
  const int t = opaque_tid(), lane = t & 63, wid = t >> 6, r32 = lane & 31, hi = lane >> 5;
  int b, hh, q0, qrow, kvh = 0;
  if (MLA) { const int qb = item & 63, bh = item >> 6; hh = bh & 7; b = bh >> 3; q0 = qb * 256; qrow = q0 + wid * 32 + r32; }
  else { const int qb = item & 255, bk = item >> 8; kvh = bk & 3; b = bk >> 2; hh = kvh * 4 + (wid >> 1); q0 = qb * 64; qrow = q0 + (wid & 1) * 32 + r32; }
  const long tok = (long)b * SEQ + qrow;
  int wlo = 0, nw = 0, NT;
  if (MLA) NT = KEYS / 64;
  else { wlo = q0 - 128 < 0 ? 0 : q0 - 128; int whi = q0 + 192 > SEQ ? SEQ : q0 + 192; nw = (whi - wlo) >> 6; NT = nw + 4; }
  auto kstart = [&](int j) -> int { if (MLA) return j * 64; return j < nw ? wlo + j * 64 : SEQ + (j - nw) * 64; };
  bf16x8 qf[KS];
  {
    const u16* qp = MLA ? (const u16*)(p.ws + OFF_Q) + tok * 1536 + hh * 192 + hi * 8 : (const u16*)(p.ws + OFF_QS) + tok * 1024 + hh * 64 + hi * 8;
#pragma unroll
    for (int s = 0; s < KS; ++s) qf[s] = *(const bf16x8*)(qp + s * 16);
  }
  const u16* kn_g; const u16* kp_g = nullptr; const u16* vt_g;
  int kn_l, kp_l = 0, vt_l; bool vswap;
  if (MLA) {
    const int kr = t >> 4, ch = t & 15;
    kn_g = (const u16*)(p.ws + OFF_KN) + ((long)b * KEYS + kr) * 1024 + hh * 128 + ch * 8;
    kn_l = kr * KPITCH + ((ch ^ ((kr >> 1) & 7)) << 4);
    const int pr = t >> 3, pc = t & 7;
    kp_g = (const u16*)(p.ws + OFF_KPE) + ((long)b * KEYS + pr) * 64 + pc * 8;
    kp_l = pr * KPITCH + 256 + ((pc ^ ((pr >> 1) & 7)) << 4);
    const int dv = t >> 3, c16 = t & 7;
    vt_g = (const u16*)(p.ws + OFF_VT) + ((long)(b * 8 + hh) * 128 + dv) * KEYS + c16 * 8;
    vt_l = dv * 128 + ((c16 ^ ((dv >> 1) & 7)) << 4);
    vswap = dv & 16;
  } else {
    const int kr = t >> 3, ch = t & 7;
    kn_g = (const u16*)(p.ws + OFF_KS) + ((long)b * KEYS + kr) * 256 + kvh * 64 + ch * 8;
    kn_l = kr * KPITCH + ((ch ^ ((kr >> 1) & 7)) << 4);
    const int dv = t >> 3, c16 = t & 7;
    vt_g = (const u16*)(p.ws + OFF_VST) + ((long)(b * 4 + kvh) * 64 + dv) * KEYS + c16 * 8;
    vt_l = dv * 128 + ((c16 ^ ((dv >> 1) & 7)) << 4);
    vswap = dv & 16;
  }
  bf16x8 sk0, sk1, skp, sv0, sv1;
  auto gload = [&](int k0) {
    if (MLA) {
      sk0 = *(const bf16x8*)(kn_g + (long)k0 * 1024);
      sk1 = *(const bf16x8*)(kn_g + (long)(k0 + 32) * 1024);
      skp = *(const bf16x8*)(kp_g + (long)k0 * 64);
      sv0 = *(const bf16x8*)(vt_g + k0);
      sv1 = *(const bf16x8*)(vt_g + (long)64 * KEYS + k0);
    } else {
      sk0 = *(const bf16x8*)(kn_g + (long)k0 * 256);
      sv0 = *(const bf16x8*)(vt_g + k0);
    }
  };
  auto vsw = [&](bf16x8 v) -> bf16x8 {
    bf16x8 w = __builtin_shufflevector(v, v, 4, 5, 6, 7, 0, 1, 2, 3);
    return vswap ? w : v;
  };
  auto lstore = [&](int buf) {
    char* kb = lds + buf * BUF; char* vb = kb + KT_BYTES;
    if (MLA) {
      *(bf16x8*)(kb + kn_l) = sk0;
      *(bf16x8*)(kb + kn_l + 32 * KPITCH) = sk1;
      *(bf16x8*)(kb + kp_l) = skp;
      *(bf16x8*)(vb + vt_l) = vsw(sv0);
      *(bf16x8*)(vb + vt_l + 64 * 128) = vsw(sv1);
    } else {
      *(bf16x8*)(kb + kn_l) = sk0;
      *(bf16x8*)(vb + vt_l) = vsw(sv0);
    }
  };
  const int xr = (r32 >> 1) & 7;
  const int krd = r32 * KPITCH;
  const int fv = (xr << 1) | ((r32 >> 4) & 1);
  const int vrd = r32 * 128;
  f32x16 o[NDB];
#pragma unroll
  for (int d = 0; d < NDB; ++d)
#pragma unroll
    for (int r = 0; r < 16; ++r) o[d][r] = 0.f;
  float m_run = -1e30f, l_run = 0.f;

  const bool grpB = false;
  gload(kstart(0)); lstore(0);
  if (grpB && NT > 1) gload(kstart(1));
  __syncthreads();
  for (int j = 0; j < NT; ++j) {
    const char* kb = lds + (j & 1) * BUF; const char* vb = kb + KT_BYTES;
    const bool more = j + 1 < NT;
    if (grpB && more) { lstore((j + 1) & 1); if (j + 2 < NT) gload(kstart(j + 2)); }
    if (!grpB && more) gload(kstart(j + 1));
    f32x16 p0, p1;
#pragma unroll
    for (int r = 0; r < 16; ++r) { p0[r] = 0.f; p1[r] = 0.f; }
#pragma unroll
    for (int s = 0; s < KS; ++s) {
      const int co = ((2 * s + hi) ^ xr) << 4;
      bf16x8 a0 = *(const bf16x8*)(kb + krd + co);
      bf16x8 a1 = *(const bf16x8*)(kb + krd + 32 * KPITCH + co);
      p0 = MFMA(a0, qf[s], p0);
      p1 = MFMA(a1, qf[s], p1);
      if ((s & 3) == 3) __builtin_amdgcn_sched_barrier(0);
    }
    if (!MLA) {
      if (j < nw) {
        const int kp0 = kstart(j) + 4 * hi - qrow;
#pragma unroll
        for (int r = 0; r < 16; ++r) {
          const int d0 = kp0 + (r & 3) + 8 * (r >> 2), d1 = d0 + 32;
          if (d0 > 128 || d0 < -128) p0[r] = -INFINITY;
          if (d1 > 128 || d1 < -128) p1[r] = -INFINITY;
        }
      }
    }
    float pmax = p0[0];
#pragma unroll
    for (int r = 1; r < 16; ++r) pmax = fmaxf(pmax, p0[r]);
#pragma unroll
    for (int r = 0; r < 16; ++r) pmax = fmaxf(pmax, p1[r]);
    pmax = xhalf_max(pmax);
    const float m_new = fmaxf(m_run, pmax);
    const float alpha = __builtin_amdgcn_exp2f(m_run - m_new);
    m_run = m_new;
    float ps = 0.f;
#pragma unroll
    for (int r = 0; r < 16; ++r) { p0[r] = __builtin_amdgcn_exp2f(p0[r] - m_new); ps += p0[r]; }
#pragma unroll
    for (int r = 0; r < 16; ++r) { p1[r] = __builtin_amdgcn_exp2f(p1[r] - m_new); ps += p1[r]; }
    l_run = l_run * alpha + ps;
    if (__any(alpha < 1.f)) {
#pragma unroll
      for (int d = 0; d < NDB; ++d) o[d] *= alpha;
    }
    bf16x8 pb[4];
#pragma unroll
    for (int s = 0; s < 2; ++s) {
      u32x4 w0 = {pk2(p0[8 * s], p0[8 * s + 1]), pk2(p0[8 * s + 2], p0[8 * s + 3]), pk2(p0[8 * s + 4], p0[8 * s + 5]), pk2(p0[8 * s + 6], p0[8 * s + 7])};
      u32x4 w1 = {pk2(p1[8 * s], p1[8 * s + 1]), pk2(p1[8 * s + 2], p1[8 * s + 3]), pk2(p1[8 * s + 4], p1[8 * s + 5]), pk2(p1[8 * s + 6], p1[8 * s + 7])};
      pb[s] = __builtin_bit_cast(bf16x8, w0);
      pb[2 + s] = __builtin_bit_cast(bf16x8, w1);
    }
#pragma unroll
    for (int d = 0; d < NDB; ++d) {
#pragma unroll
      for (int s = 0; s < 4; ++s) {
        const int c8 = 4 * s + hi;
        s16x4 lo = *(const s16x4*)(vb + vrd + d * 32 * 128 + ((c8 ^ fv) << 3));
        s16x4 hi4 = *(const s16x4*)(vb + vrd + d * 32 * 128 + (((c8 + 2) ^ fv) << 3));
        bf16x8 a = __builtin_shufflevector(lo, hi4, 0, 1, 2, 3, 4, 5, 6, 7);
        o[d] = MFMA(a, pb[s], o[d]);
      }
      __builtin_amdgcn_sched_barrier(0);
    }
    if (!grpB && more) lstore((j + 1) & 1);
    __syncthreads();
  }
  float l_tot = xhalf_sum(l_run);
  float fin = 1.f;
  if (!MLA) {
    const float sk = p.sink[hh] * LOG2E;
    const float mf = fmaxf(m_run, sk);
    const float a = __builtin_amdgcn_exp2f(m_run - mf);
    l_tot = l_tot * a + __builtin_amdgcn_exp2f(sk - mf);
    fin = a;
  }
  const float inv = fin / l_tot;
  const u16* gate = (const u16*)(p.ws + (MLA ? OFF_SGA : OFF_SGB)) + tok * 1024 + hh * DV;
  u16* outp = (u16*)(p.ws + (MLA ? OFF_GA : OFF_GB)) + tok * 1024 + hh * DV;
#pragma unroll
  for (int d = 0; d < NDB; ++d) {
#pragma unroll
    for (int g4 = 0; g4 < 4; ++g4) {
      const int dv = d * 32 + 8 * g4 + 4 * hi;
      const u32x2 gv = *(const u32x2*)(gate + dv);
      const float g0 = __uint_as_float(gv[0] << 16), g1 = __uint_as_float(gv[0] & 0xffff0000u);
      const float g2 = __uint_as_float(gv[1] << 16), g3 = __uint_as_float(gv[1] & 0xffff0000u);
      u32x2 ov = {pk2(o[d][4 * g4] * inv * g0, o[d][4 * g4 + 1] * inv * g1), pk2(o[d][4 * g4 + 2] * inv * g2, o[d][4 * g4 + 3] * inv * g3)};
      *(u32x2*)(outp + dv) = ov;
    }
  }
}
DI void attn_mla8_all(const Params& p, char* lds) {
  constexpr int KT_B = 128 * 256, VS_B = 128 * 64, VT_B = 2 * VS_B, BUF8 = KT_B + VT_B;
  const int t = opaque_tid(), lane = t & 63, wid = t >> 6, r32 = lane & 31, hi = lane >> 5;
  constexpr int NT = KEYS / 128;
  auto item_of = [&](int it, int k) -> int {
    if (gridDim.x != 256) return it;
    const int x = blockIdx.x & 7, slot = blockIdx.x >> 3;
    return (x + 8 * (k >> 1)) * 64 + (k & 1) * 32 + slot;
  };
  const int kr = t >> 3, kc = t & 7;
  const int kn_l = kr * 256 + ((kc ^ (kr & 15)) << 4);
  const int pr = t >> 2, pc = t & 3;
  const int kp_l = pr * 256 + (((8 + pc) ^ (pr & 15)) << 4);
  const int dv = t >> 2, vc = t & 3;
  const int vt_l = dv * 64 + ((vc ^ ((dv >> 2) & 3)) << 4);
  const u8 *kn_g, *kp_g, *vt_g;
  i32x8 qf[3];
  auto setptrs = [&](int item) {
    const int bh = item >> 6, hh = bh & 7, b = bh >> 3;
    const int t4 = opaque_tid(), kr = t4 >> 3, kc = t4 & 7, pr = t4 >> 2, pc = t4 & 3, dv = t4 >> 2, vc = t4 & 3;
    kn_g = (const u8*)(p.ws + OFF_KN) + ((long)b * KEYS + kr) * 1024 + hh * 128 + kc * 16;
    kp_g = (const u8*)(p.ws + OFF_KPE) + ((long)b * KEYS + pr) * 64 + pc * 16;
    vt_g = (const u8*)(p.ws + OFF_VT) + ((long)(b * 8 + hh) * 128 + dv) * KEYS + vc * 16;
  };
  auto loadq = [&](int item) {
    const int qb = item & 63, bh = item >> 6, hh = bh & 7, b = bh >> 3;
    const int t5 = opaque_tid(), lane5 = t5 & 63, wid = t5 >> 6, r32 = lane5 & 31, hi = lane5 >> 5;
    const long tk = (long)b * SEQ + qb * 256 + wid * 32 + r32;
    const u8* qp = (const u8*)(p.ws + OFF_Q) + tk * 1536 + hh * 192 + hi * 32;
#pragma unroll
    for (int s = 0; s < 3; ++s) {
      const u32x4 lo = *(const u32x4*)(qp + s * 64), hi4 = *(const u32x4*)(qp + s * 64 + 16);
      qf[s] = i32x8{(int)lo[0], (int)lo[1], (int)lo[2], (int)lo[3], (int)hi4[0], (int)hi4[1], (int)hi4[2], (int)hi4[3]};
    }
  };
  u32x4 sk0, sk1, sp, sv0, sv1;
  auto gload = [&](int k0) {
    sk0 = *(const u32x4*)(kn_g + (long)k0 * 1024);
    sk1 = *(const u32x4*)(kn_g + (long)(k0 + 64) * 1024);
    sp = *(const u32x4*)(kp_g + (long)k0 * 64);
    sv0 = *(const u32x4*)(vt_g + k0);
    sv1 = *(const u32x4*)(vt_g + k0 + 64);
  };
  auto lstore = [&](int buf) {
    char* kb = lds + buf * BUF8; char* vb = kb + KT_B;
    *(u32x4*)(kb + kn_l) = sk0;
    *(u32x4*)(kb + kn_l + 64 * 256) = sk1;
    *(u32x4*)(kb + kp_l) = sp;
    *(u32x4*)(vb + vt_l) = sv0;
    *(u32x4*)(vb + VS_B + vt_l) = sv1;
  };
  const int x15 = r32 & 15, g3 = (r32 >> 2) & 3;
  const int krd = r32 * 256, vrd = r32 * 64;
  constexpr float PSH = 4.f, THR = 4.f;
  int it = blockIdx.x, kq = 0;
  if (it >= P4_MLA_N) return;
  int item = item_of(it, 0);
  setptrs(item); loadq(item); gload(0);
  for (; it < P4_MLA_N; it += gridDim.x, ++kq) {
  const bool has_next = it + (int)gridDim.x < P4_MLA_N;
  const int item_next = has_next ? item_of(it + gridDim.x, kq + 1) : 0;
  f32x16 o[4];
#pragma unroll
  for (int d = 0; d < 4; ++d)
#pragma unroll
    for (int r = 0; r < 16; ++r) o[d][r] = 0.f;
  float m_run = 0.f, l_run = 0.f;
  lstore(0); __syncthreads();
  for (int j = 0; j < NT; ++j) {
    const char* kb = lds + (j & 1) * BUF8; const char* vb = kb + KT_B;
    const bool more = j + 1 < NT;
    if (more) gload((j + 1) * 128);
    else if (has_next) { setptrs(item_next); gload(0); }
    f32x16 pa[4];
#pragma unroll
    for (int kh = 0; kh < 4; ++kh)
#pragma unroll
      for (int r = 0; r < 16; ++r) pa[kh][r] = 0.f;
#pragma unroll
    for (int s = 0; s < 3; ++s) {
      const int c0 = ((4 * s + 2 * hi) ^ x15) << 4, c1 = ((4 * s + 2 * hi + 1) ^ x15) << 4;
#pragma unroll
      for (int kh = 0; kh < 4; ++kh) {
        const u32x4 a0 = *(const u32x4*)(kb + krd + kh * 32 * 256 + c0), a1 = *(const u32x4*)(kb + krd + kh * 32 * 256 + c1);
        const i32x8 a = {(int)a0[0], (int)a0[1], (int)a0[2], (int)a0[3], (int)a1[0], (int)a1[1], (int)a1[2], (int)a1[3]};
        pa[kh] = MFMA8(a, qf[s], pa[kh]);
      }
    }
    float pmax = pa[0][0];
#pragma unroll
    for (int kh = 0; kh < 4; ++kh)
#pragma unroll
      for (int r = 0; r < 16; ++r) pmax = fmaxf(pmax, pa[kh][r]);
    pmax = xhalf_max(pmax);
    const bool first = j == 0;
    const bool need = first || pmax - m_run > THR;
    const float m_new = need ? ceilf(pmax) : m_run;
    if (!first && __any(need)) {
      const float alpha = __builtin_amdgcn_exp2f(m_run - m_new);
      l_run *= alpha;
#pragma unroll
      for (int d = 0; d < 4; ++d) o[d] *= alpha;
    }
    m_run = m_new;
    const float psc = __builtin_amdgcn_exp2f(m_run - PSH);
    i32x8 pb0, pb1;
#pragma unroll
    for (int q = 0; q < 4; ++q) {
      pb0[q] = (int)pk4f8s(__builtin_amdgcn_exp2f(pa[0][4 * q]), __builtin_amdgcn_exp2f(pa[0][4 * q + 1]), __builtin_amdgcn_exp2f(pa[0][4 * q + 2]), __builtin_amdgcn_exp2f(pa[0][4 * q + 3]), psc);
      pb0[4 + q] = (int)pk4f8s(__builtin_amdgcn_exp2f(pa[1][4 * q]), __builtin_amdgcn_exp2f(pa[1][4 * q + 1]), __builtin_amdgcn_exp2f(pa[1][4 * q + 2]), __builtin_amdgcn_exp2f(pa[1][4 * q + 3]), psc);
      pb1[q] = (int)pk4f8s(__builtin_amdgcn_exp2f(pa[2][4 * q]), __builtin_amdgcn_exp2f(pa[2][4 * q + 1]), __builtin_amdgcn_exp2f(pa[2][4 * q + 2]), __builtin_amdgcn_exp2f(pa[2][4 * q + 3]), psc);
      pb1[4 + q] = (int)pk4f8s(__builtin_amdgcn_exp2f(pa[3][4 * q]), __builtin_amdgcn_exp2f(pa[3][4 * q + 1]), __builtin_amdgcn_exp2f(pa[3][4 * q + 2]), __builtin_amdgcn_exp2f(pa[3][4 * q + 3]), psc);
    }
    const int one4 = 0x38383838;
    const i32x8 ones = {one4, one4, one4, one4, one4, one4, one4, one4};
    f32x16 ls;
#pragma unroll
    for (int r = 0; r < 16; ++r) ls[r] = 0.f;
    ls = MFMA8(ones, pb0, ls);
    ls = MFMA8(ones, pb1, ls);
#pragma unroll
    for (int d = 0; d < 4; ++d) {
      const u32x4 v0 = *(const u32x4*)(vb + vrd + d * 32 * 64 + (((2 * hi) ^ g3) << 4));
      const u32x4 v1 = *(const u32x4*)(vb + vrd + d * 32 * 64 + (((2 * hi + 1) ^ g3) << 4));
      const u32x4 w0 = *(const u32x4*)(vb + VS_B + vrd + d * 32 * 64 + (((2 * hi) ^ g3) << 4));
      const u32x4 w1 = *(const u32x4*)(vb + VS_B + vrd + d * 32 * 64 + (((2 * hi + 1) ^ g3) << 4));
      const i32x8 a = {(int)v0[0], (int)v0[1], (int)v0[2], (int)v0[3], (int)v1[0], (int)v1[1], (int)v1[2], (int)v1[3]};
      const i32x8 c = {(int)w0[0], (int)w0[1], (int)w0[2], (int)w0[3], (int)w1[0], (int)w1[1], (int)w1[2], (int)w1[3]};
      o[d] = MFMA8(a, pb0, o[d]);
      o[d] = MFMA8(c, pb1, o[d]);
    }
    l_run += ls[0];
    if (more) lstore((j + 1) & 1);
    __syncthreads();
  }
  const int te = opaque_tid(), lane_e = te & 63, wid_e = te >> 6, r32e = lane_e & 31, hie = lane_e >> 5;
  const int qbc = item & 63, bhc = item >> 6, hh = bhc & 7, bc = bhc >> 3;
  const long tok = (long)bc * SEQ + qbc * 256 + wid_e * 32 + r32e;
  const float inv = 1.f / l_run;
  const u16* gate = (const u16*)(p.ws + OFF_SGA) + tok * 1024 + hh * 128;
  u16* outp = (u16*)(p.ws + OFF_GA) + tok * 1024 + hh * 128;
#pragma unroll
  for (int d = 0; d < 4; ++d) {
#pragma unroll
    for (int g4 = 0; g4 < 4; ++g4) {
      const int dvo = d * 32 + 8 * g4 + 4 * hie;
      const u32x2 gv = *(const u32x2*)(gate + dvo);
      const float g0 = __uint_as_float(gv[0] << 16), g1 = __uint_as_float(gv[0] & 0xffff0000u);
      const float g2 = __uint_as_float(gv[1] << 16), g3f = __uint_as_float(gv[1] & 0xffff0000u);
      u32x2 ov = {pk2(o[d][4 * g4] * inv * g0, o[d][4 * g4 + 1] * inv * g1), pk2(o[d][4 * g4 + 2] * inv * g2, o[d][4 * g4 + 3] * inv * g3f)};
      *(u32x2*)(outp + dvo) = ov;
    }
  }
  if (has_next) loadq(item_next);
  item = item_next;
  }
}
DI void attn_swa_all(const Params& p, char* lds) {
  constexpr int TB = 16384, KPITCH = 128;
  const int t = opaque_tid(), lane = t & 63, wid = t >> 6, r32 = lane & 31, hi = lane >> 5;
  const int srow = t >> 3, sch = t & 7;
  const int st_l = srow * 128 + ((sch ^ ((srow >> 1) & 7)) << 4);
  const bool vswap = srow & 16;
  const int xr = (r32 >> 1) & 7;
  const int krd = r32 * KPITCH;
  const int fv = (xr << 1) | ((r32 >> 4) & 1);
  const int vrd = r32 * 128;
  bf16x8 sk[9], sv[9];
  auto geom = [&](int item, int& b, int& kvh, int& q0, int& wlo, int& nw) {
    const int qb = item & 255, bk = item >> 8; kvh = bk & 3; b = bk >> 2; q0 = qb * 64;
    wlo = q0 - 128 < 0 ? 0 : q0 - 128; const int whi = q0 + 192 > SEQ ? SEQ : q0 + 192; nw = (whi - wlo) >> 6;
  };
  auto gload_item = [&](int item) {
    int b, kvh, q0, wlo, nw; geom(item, b, kvh, q0, wlo, nw);
    const u16* kg = (const u16*)(p.ws + OFF_KS) + ((long)b * KEYS + srow) * 256 + kvh * 64 + sch * 8;
    const u16* vg = (const u16*)(p.ws + OFF_VST) + ((long)(b * 4 + kvh) * 64 + srow) * KEYS + sch * 8;
#pragma unroll
    for (int j = 0; j < 9; ++j) {
      if (j < nw + 4) {
        const int k0 = j < nw ? wlo + j * 64 : SEQ + (j - nw) * 64;
        sk[j] = *(const bf16x8*)(kg + (long)k0 * 256);
        sv[j] = *(const bf16x8*)(vg + k0);
      }
    }
  };
  bf16x8 qf[4];
  auto loadq = [&](int itm) {
    int b2, kvh2, q02, wlo2, nw2; geom(itm, b2, kvh2, q02, wlo2, nw2);
    const int t6 = opaque_tid(), lane6 = t6 & 63, wid6 = t6 >> 6;
    const long tk = (long)b2 * SEQ + q02 + (wid6 & 1) * 32 + (lane6 & 31);
    const u16* qp = (const u16*)(p.ws + OFF_QS) + tk * 1024 + (kvh2 * 4 + (wid6 >> 1)) * 64 + (lane6 >> 5) * 8;
#pragma unroll
    for (int s = 0; s < 4; ++s) qf[s] = *(const bf16x8*)(qp + s * 16);
  };
  int item = blockIdx.x;
  if (item < P4_SWA_N) { gload_item(item); loadq(item); }
  for (; item < P4_SWA_N; item += gridDim.x) {
    int b, kvh, q0, wlo, nw; geom(item, b, kvh, q0, wlo, nw);
    const int NT = nw + 4;
    __syncthreads();
#pragma unroll
    for (int j = 0; j < 9; ++j) {
      if (j < NT) {
        *(bf16x8*)(lds + j * TB + st_l) = sk[j];
        const bf16x8 w = __builtin_shufflevector(sv[j], sv[j], 4, 5, 6, 7, 0, 1, 2, 3);
        *(bf16x8*)(lds + j * TB + 8192 + st_l) = vswap ? w : sv[j];
      }
    }
    __syncthreads();
    if (item + (int)gridDim.x < P4_SWA_N) gload_item(item + gridDim.x);
    const int hh = kvh * 4 + (wid >> 1);
    const int qrow = q0 + (wid & 1) * 32 + r32;
    const long tok = (long)b * SEQ + qrow;
    f32x16 o[2];
#pragma unroll
    for (int d = 0; d < 2; ++d)
#pragma unroll
      for (int r = 0; r < 16; ++r) o[d][r] = 0.f;
    float m_run = -1e30f, l_run = 0.f;
    for (int j = 0; j < NT; ++j) {
      const char* kb = lds + j * TB; const char* vb = kb + 8192;
      f32x16 p0, p1;
#pragma unroll
      for (int r = 0; r < 16; ++r) { p0[r] = 0.f; p1[r] = 0.f; }
#pragma unroll
      for (int s = 0; s < 4; ++s) {
        const int co = ((2 * s + hi) ^ xr) << 4;
        bf16x8 a0 = *(const bf16x8*)(kb + krd + co);
        bf16x8 a1 = *(const bf16x8*)(kb + krd + 32 * KPITCH + co);
        p0 = MFMA(a0, qf[s], p0);
        p1 = MFMA(a1, qf[s], p1);
      }
      if (j < nw) {
        const int kp0 = wlo + j * 64 + 4 * hi - qrow;
#pragma unroll
        for (int r = 0; r < 16; ++r) {
          const int d0 = kp0 + (r & 3) + 8 * (r >> 2), d1 = d0 + 32;
          if (d0 > 128 || d0 < -128) p0[r] = -INFINITY;
          if (d1 > 128 || d1 < -128) p1[r] = -INFINITY;
        }
      }
      float pmax = p0[0];
#pragma unroll
      for (int r = 1; r < 16; ++r) pmax = fmaxf(pmax, p0[r]);
#pragma unroll
      for (int r = 0; r < 16; ++r) pmax = fmaxf(pmax, p1[r]);
      pmax = xhalf_max(pmax);
      const float m_new = fmaxf(m_run, pmax);
      const float alpha = __builtin_amdgcn_exp2f(m_run - m_new);
      m_run = m_new;
      float ps = 0.f;
#pragma unroll
      for (int r = 0; r < 16; ++r) { p0[r] = __builtin_amdgcn_exp2f(p0[r] - m_new); ps += p0[r]; }
#pragma unroll
      for (int r = 0; r < 16; ++r) { p1[r] = __builtin_amdgcn_exp2f(p1[r] - m_new); ps += p1[r]; }
      l_run = l_run * alpha + ps;
      if (__any(alpha < 1.f)) {
#pragma unroll
        for (int d = 0; d < 2; ++d) o[d] *= alpha;
      }
      bf16x8 pb[4];
#pragma unroll
      for (int s = 0; s < 2; ++s) {
        u32x4 w0 = {pk2(p0[8 * s], p0[8 * s + 1]), pk2(p0[8 * s + 2], p0[8 * s + 3]), pk2(p0[8 * s + 4], p0[8 * s + 5]), pk2(p0[8 * s + 6], p0[8 * s + 7])};
        u32x4 w1 = {pk2(p1[8 * s], p1[8 * s + 1]), pk2(p1[8 * s + 2], p1[8 * s + 3]), pk2(p1[8 * s + 4], p1[8 * s + 5]), pk2(p1[8 * s + 6], p1[8 * s + 7])};
        pb[s] = __builtin_bit_cast(bf16x8, w0);
        pb[2 + s] = __builtin_bit_cast(bf16x8, w1);
      }
#pragma unroll
      for (int d = 0; d < 2; ++d) {
#pragma unroll
        for (int s = 0; s < 4; ++s) {
          const int c8 = 4 * s + hi;
          s16x4 lo = *(const s16x4*)(vb + vrd + d * 32 * 128 + ((c8 ^ fv) << 3));
          s16x4 hi4 = *(const s16x4*)(vb + vrd + d * 32 * 128 + (((c8 + 2) ^ fv) << 3));
          bf16x8 a = __builtin_shufflevector(lo, hi4, 0, 1, 2, 3, 4, 5, 6, 7);
          o[d] = MFMA(a, pb[s], o[d]);
        }
      }
    }
    if (item + (int)gridDim.x < P4_SWA_N) loadq(item + gridDim.x);
    const int t3 = opaque_tid(), lane3 = t3 & 63, wid3 = t3 >> 6, r32c = lane3 & 31, hic = lane3 >> 5;
    const int hh3 = kvh * 4 + (wid3 >> 1);
    const long tok3 = (long)b * SEQ + q0 + (wid3 & 1) * 32 + r32c;
    float l_tot = xhalf_sum(l_run);
    const float skl = p.sink[hh3] * LOG2E;
    const float mf = fmaxf(m_run, skl);
    const float af = __builtin_amdgcn_exp2f(m_run - mf);
    l_tot = l_tot * af + __builtin_amdgcn_exp2f(skl - mf);
    const float inv = af / l_tot;
    const u16* gate = (const u16*)(p.ws + OFF_SGB) + tok3 * 1024 + hh3 * 64;
    u16* outp = (u16*)(p.ws + OFF_GB) + tok3 * 1024 + hh3 * 64;
#pragma unroll
    for (int d = 0; d < 2; ++d) {
#pragma unroll
      for (int g4 = 0; g4 < 4; ++g4) {
        const int dv = d * 32 + 8 * g4 + 4 * hic;
        const u32x2 gv = *(const u32x2*)(gate + dv);
        const float g0 = __uint_as_float(gv[0] << 16), g1 = __uint_as_float(gv[0] & 0xffff0000u);
        const float g2 = __uint_as_float(gv[1] << 16), g3 = __uint_as_float(gv[1] & 0xffff0000u);
        u32x2 ov = {pk2(o[d][4 * g4] * inv * g0, o[d][4 * g4 + 1] * inv * g1), pk2(o[d][4 * g4 + 2] * inv * g2, o[d][4 * g4 + 3] * inv * g3)};
        *(u32x2*)(outp + dv) = ov;
      }
    }
  }
}
constexpr int P4_MLA = NB * 8 * 64, P4_SWA = NB * 4 * 256;
DI void phase4(const Params& p, char* lds) {
  attn_mla8_all(p, lds);
  __syncthreads();
  attn_swa_all(p, lds);
}

DI void phase5(const Params& p, char* lds) {
  for (int t = blockIdx.x; t < 128 * 8; t += gridDim.x) {
    const int tid_ = opaque_tid();
    const int lane = tid_ & 63, wid = tid_ >> 6, r32 = lane & 31, hi = lane >> 5, wm = wid >> 2, wn = wid & 3;
    const int tp = tperm(t); const int g = tp / 128, wv = tp % 128, mt = g * 16 + (wv & 15), nt = wv >> 4;
    f32x16 acc[4][2];
    zero_acc(acc);
    gemm_mainloop<true>(acc, (const u16*)(p.ws + OFF_GA) + (long)mt * 256 * 1024, 1024, (const u16*)(p.ws + OFF_WBA) + (long)nt * 256 * 1024, 1024, 16, lds);
    const u16* sa = (const u16*)(p.ws + OFF_MGA);
    const u16* sb = (const u16*)(p.ws + OFF_MGB);
    const int tid1 = opaque_tid(); const int lane1 = tid1 & 63, wid1 = tid1 >> 6;
#pragma unroll
    for (int mi = 0; mi < 4; ++mi)
#pragma unroll
      for (int ni = 0; ni < 2; ++ni) {
        const long fo = ((((long)(mt * 8 + nt) * 8 + wid1) * 4 + mi) * 2 + ni) * 1024 + lane1 * 16;
        const u32x4 a0 = *(const u32x4*)(sa + fo), a1 = *(const u32x4*)(sa + fo + 8);
        const u32x4 b0 = *(const u32x4*)(sb + fo), b1 = *(const u32x4*)(sb + fo + 8);
#pragma unroll
        for (int q = 0; q < 4; ++q) {
          acc[mi][ni][2 * q] *= __uint_as_float(a0[q] << 16) * __builtin_amdgcn_rcpf(__uint_as_float(b0[q] << 16));
          acc[mi][ni][2 * q + 1] *= __uint_as_float(a0[q] & 0xffff0000u) * __builtin_amdgcn_rcpf(__uint_as_float(b0[q] & 0xffff0000u));
          acc[mi][ni][8 + 2 * q] *= __uint_as_float(a1[q] << 16) * __builtin_amdgcn_rcpf(__uint_as_float(b1[q] << 16));
          acc[mi][ni][8 + 2 * q + 1] *= __uint_as_float(a1[q] & 0xffff0000u) * __builtin_amdgcn_rcpf(__uint_as_float(b1[q] & 0xffff0000u));
        }
      }
    gemm_mainloop<true>(acc, (const u16*)(p.ws + OFF_GB) + (long)mt * 256 * 1024, 1024, (const u16*)(p.ws + OFF_WBB) + (long)nt * 256 * 1024, 1024, 16, lds);
    const int tid2 = opaque_tid();
    const int lane2 = tid2 & 63, wid2 = tid2 >> 6, r32b = lane2 & 31, hib = lane2 >> 5, wmb = wid2 >> 2, wnb = wid2 & 3;
#pragma unroll
    for (int mi = 0; mi < 4; ++mi)
#pragma unroll
      for (int ni = 0; ni < 2; ++ni) {
        const long mb = mt * 256 + wmb * 128 + mi * 32 + 4 * hib; const int n = nt * 256 + wnb * 64 + ni * 32 + r32b;
        const long fo = ((((long)(mt * 8 + nt) * 8 + wid2) * 4 + mi) * 2 + ni) * 1024 + lane2 * 16;
        const u32x4 b0 = *(const u32x4*)(sb + fo), b1 = *(const u32x4*)(sb + fo + 8);
#pragma unroll
        for (int q = 0; q < 4; ++q) {
          acc[mi][ni][2 * q] *= __uint_as_float(b0[q] << 16);
          acc[mi][ni][2 * q + 1] *= __uint_as_float(b0[q] & 0xffff0000u);
          acc[mi][ni][8 + 2 * q] *= __uint_as_float(b1[q] << 16);
          acc[mi][ni][8 + 2 * q + 1] *= __uint_as_float(b1[q] & 0xffff0000u);
        }
        store_rows((u16*)(p.ws + OFF_M), 2048, mb, n, acc[mi][ni]);
        asm volatile("" ::: "memory"); __builtin_amdgcn_sched_barrier(0);
      }
  }
}

DI void phase6(const Params& p, char* lds) {
  const float* mod = (const float*)(p.ws + OFF_MOD);
  for (int t = blockIdx.x; t < 128 * 8; t += gridDim.x) {
    const int tid_ = opaque_tid();
    const int lane = tid_ & 63, wid = tid_ >> 6, r32 = lane & 31, hi = lane >> 5, wm = wid >> 2, wn = wid & 3;
    const int tp = tperm(t); const int g = tp / 128, wv = tp % 128, mt = g * 16 + (wv & 15), nt = wv >> 4;
    f32x16 acc[4][2];
    zero_acc(acc);
    gemm_mainloop(acc, (const u16*)(p.ws + OFF_M) + (long)mt * 256 * 2048, 2048, (const u16*)(p.ws + OFF_WO) + (long)nt * 256 * 2048, 2048, 32, lds);
    const int bidx = mt >> 6;
#pragma unroll
    for (int ni = 0; ni < 2; ++ni) {
      const int n = nt * 256 + wn * 64 + ni * 32 + r32;
      const float gt = mod[bidx * 6144 + 4096 + n];
#pragma unroll
      for (int mi = 0; mi < 4; ++mi) {
        const long mb = mt * 256 + wm * 128 + mi * 32 + 4 * hi;
        store_rows((u16*)(p.ws + OFF_DLT), 2048, mb, n, acc[mi][ni] * gt);
      }
    }
  }
}

DI void phase7(const Params& p) {
  const int lane = threadIdx.x & 63, wid = threadIdx.x >> 6;
  const u16* dl = (const u16*)(p.ws + OFF_DLT);
  const int stride = gridDim.x * 8;
  int row = blockIdx.x * 8 + wid;
  f32x4 xv[8], xn[8];
  u32x2 dv[8], dn[8];
  if (row < T_LAT) {
#pragma unroll
    for (int i = 0; i < 8; ++i) {
      const int col = (i * 64 + lane) * 4;
      xv[i] = *(const f32x4*)(p.x + (long)row * DM + col);
      dv[i] = *(const u32x2*)(dl + (long)row * DM + col);
    }
  }
  for (; row < T_LAT; row += stride) {
    const int nrow = row + stride;
    if (nrow < T_LAT) {
#pragma unroll
      for (int i = 0; i < 8; ++i) {
        const int col = (i * 64 + lane) * 4;
        xn[i] = *(const f32x4*)(p.x + (long)nrow * DM + col);
        dn[i] = *(const u32x2*)(dl + (long)nrow * DM + col);
      }
    }
    float* yr = p.out + (long)row * DM;
    f32x4 y[8];
    float ss = 0.f;
#pragma unroll
    for (int i = 0; i < 8; ++i) {
      y[i][0] = xv[i][0] + __uint_as_float(dv[i][0] << 16);
      y[i][1] = xv[i][1] + __uint_as_float(dv[i][0] & 0xffff0000u);
      y[i][2] = xv[i][2] + __uint_as_float(dv[i][1] << 16);
      y[i][3] = xv[i][3] + __uint_as_float(dv[i][1] & 0xffff0000u);
      ss += y[i][0] * y[i][0] + y[i][1] * y[i][1] + y[i][2] * y[i][2] + y[i][3] * y[i][3];
    }
#pragma unroll
    for (int o = 1; o < 64; o <<= 1) ss += __shfl_xor(ss, o);
    const float rstd = rsqrtf(ss * (1.f / DM) + EPSN);
#pragma unroll
    for (int i = 0; i < 8; ++i) {
      const int col = (i * 64 + lane) * 4;
      const f32x4 g = *(const f32x4*)(p.final_g + col);
      *(f32x4*)(yr + col) = y[i] * rstd * g;
    }
#pragma unroll
    for (int i = 0; i < 8; ++i) { xv[i] = xn[i]; dv[i] = dn[i]; }
  }
}

__global__ void __launch_bounds__(512) mega(Params p, int ph_lo, int ph_hi) {
  __shared__ __attribute__((aligned(16))) char lds[LDS_BYTES];
  cg::grid_group grid = cg::this_grid();
#define RUN(ph, call) do { if (ph_lo <= (ph) && (ph) < ph_hi) { call; if ((ph) + 1 < ph_hi) { asm volatile("s_waitcnt vmcnt(0) lgkmcnt(0)" ::: "memory"); grid.sync(); } } } while (0)
  RUN(0, phase0(p, lds));
  RUN(1, phase1(p));
  RUN(2, phase2(p, lds));
  RUN(3, phase3(p, lds));
  RUN(4, phase4(p, lds));
  RUN(5, phase5(p, lds));
  RUN(6, phase6(p, lds));
  RUN(7, phase7(p));
#undef RUN
}

extern "C" void kernel_launch(void* const* d_in, const int* in_sizes, int n_in, void* d_out, int out_size, void* d_ws, size_t ws_size, hipStream_t stream) {
  static int grid_blocks = 0;
  if (!grid_blocks) {
    int dev = 0, cus = 0, per_cu = 0;
    hipGetDevice(&dev);
    hipDeviceGetAttribute(&cus, hipDeviceAttributeMultiprocessorCount, dev);
    hipOccupancyMaxActiveBlocksPerMultiprocessor(&per_cu, mega, 512, 0);
    if (per_cu < 1) per_cu = 1;
    if (per_cu > 1) per_cu = 1;
    grid_blocks = cus * per_cu;
    if (ws_size < WS_END) fprintf(stderr, "kernel_launch: workspace too small: %zu < %zu\n", ws_size, WS_END);
  }
  Params p{};
  p.x = (const float*)d_in[0]; p.c = (const float*)d_in[1]; p.ctx = (const float*)d_in[2]; p.c_ctx = (const float*)d_in[3];
  p.w_ada = (const float*)d_in[4]; p.b_ada = (const float*)d_in[5]; p.norm_g = (const float*)d_in[6]; p.w_in = (const float*)d_in[7];
  p.b_in = (const float*)d_in[8]; p.qn_g = (const float*)d_in[9]; p.kvn_g = (const float*)d_in[10]; p.w_uq = (const float*)d_in[11];
  p.w_ukv = (const float*)d_in[12]; p.sink = (const float*)d_in[13]; p.w_ba = (const float*)d_in[14]; p.w_bb = (const float*)d_in[15];
  p.w_o = (const float*)d_in[16]; p.final_g = (const float*)d_in[17];
  p.out = (float*)d_out; p.ws = (char*)d_ws;
#if MULTI_LAUNCH
  for (int ph = 0; ph < 8; ++ph) hipLaunchKernelGGL(mega, dim3(grid_blocks), dim3(512), 0, stream, p, ph, ph + 1);
#else
  int lo = 0, hi = 8;
  void* args[] = {&p, &lo, &hi};
  hipError_t e = hipLaunchCooperativeKernel((void*)mega, dim3(grid_blocks), dim3(512), args, 0, stream);
  if (e != hipSuccess) fprintf(stderr, "cooperative launch failed: %s (grid %d)\n", hipGetErrorString(e), grid_blocks);
#endif
}
```
